# Optimizing an MI355X kernel written in HIP

```python
import math
import jax, jax.numpy as jnp
from jax import lax
import numpy as np

D_MODEL = 1024
BATCH = 32
SEQ = 2048
DEPTH = 1
DEC_BATCH = 8
DEC_SEQ = 16
PAST_LEN = 1024

CHUNK = 64
DK_A = 128
DV_A = 128
H_A = D_MODEL // 128
QK_A = H_A * DK_A
V_A = H_A * DV_A
CONV_W = 4
CONV_CH = 2 * QK_A + V_A
N_B = 64
H_B = D_MODEL // N_B
D_B = H_B * N_B
LORA_W = 64
LORA_A = 64
LORA_G = 128
D_FF = 4 * D_MODEL
COLS_A = CONV_CH + V_A + 2 * H_A
COLS_B = 3 * D_B + LORA_W + LORA_A + LORA_G
COLS_IN = COLS_A + COLS_B + 2 * D_MODEL
DN_ALPHA = (2 * DEPTH) ** 0.25
DN_BETA = (8 * DEPTH) ** -0.25
LN_EPS = 1e-5
NORM_EPS = 1e-6
GN_EPS = 64e-5

kernel_name = 'stream_hybrid_gdn_rwkv7_step'


def _layer_norm(x, g, b):
    xf = x.astype(jnp.float32)
    mu = jnp.mean(xf, -1, keepdims=True)
    var = jnp.mean(jnp.square(xf - mu), -1, keepdims=True)
    return ((xf - mu) * lax.rsqrt(var + LN_EPS) * g + b).astype(x.dtype)


def _l2norm(x):
    return x * lax.rsqrt(jnp.sum(jnp.square(x), -1, keepdims=True) + NORM_EPS)


def _causal_conv(u, buf, w):
    T = u.shape[1]
    full = jnp.concatenate([buf.astype(u.dtype), u], axis=1)
    out = full[:, 0:T] * w[0]
    for j in range(1, CONV_W):
        out = out + full[:, j:j + T] * w[j]
    return jax.nn.silu(out), full[:, T:]


def _gdn_chunked(q, k, v, g, beta, s0):
    Bn, T = q.shape[:2]
    pad = (-T) % CHUNK
    n = (T + pad) // CHUNK

    def blocks(t):
        t = jnp.pad(t, [(0, 0), (0, pad)] + [(0, 0)] * (t.ndim - 2))
        t = t.reshape((Bn, n, CHUNK) + t.shape[2:])
        return jnp.moveaxis(t, (1, 3), (0, 2))

    qb, kb, vb, gb, bb = (blocks(t) for t in (q, k, v, g, beta))
    gc = jnp.cumsum(gb, axis=-1)
    idx = jnp.arange(CHUNK)
    incl = idx[:, None] >= idx[None, :]
    strict = idx[:, None] > idx[None, :]
    decay = jnp.exp(jnp.where(incl, gc[..., :, None] - gc[..., None, :], -jnp.inf))
    kbeta = kb * bb[..., None]
    a_mat = jnp.einsum('nbhik,nbhjk->nbhij', kbeta, kb) * decay * strict
    lhs = a_mat + jnp.eye(CHUNK, dtype=a_mat.dtype)
    rhs = jnp.concatenate([vb * bb[..., None], kbeta * jnp.exp(gc)[..., None]], axis=-1)
    sol = lax.linalg.triangular_solve(lhs, rhs, left_side=True, lower=True, unit_diagonal=True)
    u, w = sol[..., :DV_A], sol[..., DV_A:]
    qk = jnp.einsum('nbhik,nbhjk->nbhij', qb, kb) * decay

    def step(S, inp):
        qi, ki, ui, wi, gi, qki = inp
        v_new = ui - jnp.einsum('bhck,bhkv->bhcv', wi, S)
        o = (jnp.einsum('bhck,bhkv->bhcv', qi * jnp.exp(gi)[..., None], S)
             + jnp.einsum('bhij,bhjv->bhiv', qki, v_new))
        g_last = gi[..., -1:]
        S = (S * jnp.exp(g_last)[..., None]
             + jnp.einsum('bhck,bhcv->bhkv', ki * jnp.exp(g_last - gi)[..., None], v_new))
        return S, o

    s_new, o = lax.scan(step, s0, (qb, kb, u, w, gc, qk))
    o = jnp.moveaxis(o, (0, 2), (1, 3)).reshape(Bn, n * CHUNK, H_A, DV_A)[:, :T]
    return o, s_new


def _gdn_branch(qkv_raw, z, beta_raw, a_raw, conv_buf, s0, conv_a_w, a_log, dt_bias, gdn_norm_g):
    f32 = jnp.float32
    Bn, T, _ = qkv_raw.shape
    qkv, conv_new = _causal_conv(qkv_raw, conv_buf, conv_a_w)
    qkv = qkv.astype(f32)
    q = _l2norm(qkv[..., :QK_A].reshape(Bn, T, H_A, DK_A)) * (DK_A ** -0.5)
    k = _l2norm(qkv[..., QK_A:2 * QK_A].reshape(Bn, T, H_A, DK_A))
    v = qkv[..., 2 * QK_A:].reshape(Bn, T, H_A, DV_A)
    beta = jax.nn.sigmoid(beta_raw.astype(f32))
    g = -jnp.exp(a_log.astype(f32)) * jax.nn.softplus(a_raw.astype(f32) + dt_bias.astype(f32))
    o, s_new = _gdn_chunked(q, k, v, g, beta, s0.astype(f32))
    o = o * lax.rsqrt(jnp.mean(jnp.square(o), -1, keepdims=True) + NORM_EPS) * gdn_norm_g.astype(f32)
    o = o * jax.nn.silu(z.astype(f32)).reshape(Bn, T, H_A, DV_A)
    return o.reshape(Bn, T, V_A).astype(z.dtype), conv_new, s_new.astype(z.dtype)


def _wkv7_scan(r, w, k, v, a, b, s0):
    def step(S, inp):
        rt, wt, kt, vt, at, bt = inp
        sa = jnp.einsum('bhij,bhj->bhi', S, at)
        S = S * wt[:, :, None, :] + sa[..., None] * bt[:, :, None, :] + vt[..., None] * kt[:, :, None, :]
        return S, jnp.einsum('bhij,bhj->bhi', S, rt)

    xs = tuple(jnp.moveaxis(t, 1, 0) for t in (r, w, k, v, a, b))
    s_new, y = lax.scan(step, s0, xs)
    return jnp.moveaxis(y, 0, 1), s_new


def _rwkv7_branch(proj_b, shift_buf, s0, mu_b, w0, w_up, a0, a_up, g_up, k_k, k_a, r_k, lnx_g, lnx_b):
    f32 = jnp.float32
    Bn, T, _ = proj_b.shape
    prev = jnp.concatenate([shift_buf[:, None].astype(proj_b.dtype), proj_b[:, :-1]], axis=1)
    xs = (proj_b + mu_b * (prev - proj_b)).astype(f32)
    r, k, v, wd, ad, gd = jnp.split(
        xs, [D_B, 2 * D_B, 3 * D_B, 3 * D_B + LORA_W, 3 * D_B + LORA_W + LORA_A], axis=-1)
    w_log = -jax.nn.softplus(-(w0 + jnp.tanh(wd) @ w_up)) - 0.5
    decay = jnp.exp(-jnp.exp(w_log))
    a = jax.nn.sigmoid(a0 + ad @ a_up)
    gate = jax.nn.sigmoid(gd) @ g_up

    def heads(t):
        return t.reshape(Bn, T, H_B, N_B)

    kk = _l2norm(heads(k * k_k))
    k = k * (1.0 + (a - 1.0) * k_a)
    r_h, k_h, v_h, a_h = heads(r), heads(k), heads(v), heads(a)
    y, s_new = _wkv7_scan(r_h, heads(decay), k_h, v_h, -kk, kk * a_h, s0.astype(f32))
    mu = jnp.mean(y, -1, keepdims=True)
    var = jnp.mean(jnp.square(y - mu), -1, keepdims=True)
    y = ((y - mu) * lax.rsqrt(var + GN_EPS)).reshape(Bn, T, D_B) * lnx_g + lnx_b
    y = y + (jnp.sum(r_h * k_h * r_k, -1, keepdims=True) * v_h).reshape(Bn, T, D_B)
    return (y * gate).astype(proj_b.dtype), proj_b[:, -1], s_new.astype(proj_b.dtype)


def _layer(x, conv_buf, s_gdn, shift_buf, s_wkv,
           w_in, conv_a_w, a_log, dt_bias, gdn_norm_g, mu_b, w0, w_up, a0, a_up, g_up,
           k_k, k_a, r_k, lnx_g, lnx_b, w_out, ln1_g, ln1_b, w_ff1, w_ff2, ln2_g, ln2_b):
    proj = jnp.einsum('btd,dc->btc', x, w_in)
    qkv_raw, z, beta_raw, a_raw, proj_b, gate_a, gate_b = jnp.split(
        proj, [CONV_CH, CONV_CH + V_A, CONV_CH + V_A + H_A, COLS_A, COLS_A + COLS_B,
               COLS_A + COLS_B + D_MODEL], axis=-1)
    o_a, conv_new, s_gdn_new = _gdn_branch(qkv_raw, z, beta_raw, a_raw, conv_buf, s_gdn,
                                           conv_a_w, a_log, dt_bias, gdn_norm_g)
    o_b, shift_new, s_wkv_new = _rwkv7_branch(proj_b, shift_buf, s_wkv, mu_b, w0, w_up, a0, a_up,
                                              g_up, k_k, k_a, r_k, lnx_g, lnx_b)
    merged = jax.nn.sigmoid(gate_a) * o_a + jax.nn.sigmoid(gate_b) * o_b
    mix = jnp.einsum('btc,cd->btd', merged, w_out)
    h = _layer_norm(DN_ALPHA * x + mix, ln1_g, ln1_b)
    ff = jnp.einsum('btf,fd->btd', jnp.square(jax.nn.relu(jnp.einsum('btd,df->btf', h, w_ff1))), w_ff2)
    y = _layer_norm(DN_ALPHA * h + ff, ln2_g, ln2_b)
    return y, conv_new, s_gdn_new, shift_new, s_wkv_new


def setup_inputs(seed: int = 0) -> dict:
    key = jax.random.key(seed)
    ks = jax.random.split(key, 29)
    f32 = jnp.float32
    L = DEPTH

    def nrm(k, shape, scale):
        return jax.random.normal(k, shape, f32) * scale

    def unif(k, shape, lo, hi):
        return jax.random.uniform(k, shape, f32, minval=lo, maxval=hi)

    dt = jnp.exp(unif(ks[9], (L, H_A), math.log(1e-3), math.log(1e-1)))
    return {
        'x_prompt': nrm(ks[0], (BATCH, SEQ, D_MODEL), 1.0),
        'x_sample': nrm(ks[1], (DEC_BATCH, DEC_SEQ, D_MODEL), 1.0),
        'state_conv_a': nrm(ks[2], (L, DEC_BATCH, CONV_W - 1, CONV_CH), 1.0),
        'state_gdn': nrm(ks[3], (L, DEC_BATCH, H_A, DK_A, DV_A), 0.3),
        'state_shift_b': nrm(ks[4], (L, DEC_BATCH, COLS_B), 1.0),
        'state_wkv': nrm(ks[5], (L, DEC_BATCH, H_B, N_B, N_B), 0.3),
        'w_in': nrm(ks[6], (L, D_MODEL, COLS_IN), D_MODEL ** -0.5),
        'conv_a_w': nrm(ks[7], (L, CONV_W, CONV_CH), CONV_W ** -0.5),
        'a_log': jnp.log(unif(ks[8], (L, H_A), 1.0, 16.0)),
        'dt_bias': dt + jnp.log(-jnp.expm1(-dt)),
        'gdn_norm_g': 1.0 + nrm(ks[10], (L, DV_A), 0.02),
        'mu_b': unif(ks[11], (L, COLS_B), 0.0, 1.0),
        'w0': unif(ks[12], (L, D_B), -4.0, 0.5),
        'w_up': nrm(ks[13], (L, LORA_W, D_B), 0.1 * LORA_W ** -0.5),
        'a0': nrm(ks[14], (L, D_B), 0.1),
        'a_up': nrm(ks[15], (L, LORA_A, D_B), LORA_A ** -0.5),
        'g_up': nrm(ks[16], (L, LORA_G, D_B), LORA_G ** -0.5),
        'k_k': 0.85 + nrm(ks[17], (L, D_B), 0.05),
        'k_a': 1.0 + nrm(ks[18], (L, D_B), 0.05),
        'r_k': nrm(ks[19], (L, H_B, N_B), 0.1),
        'lnx_g': 1.0 + nrm(ks[20], (L, D_B), 0.02),
        'lnx_b': nrm(ks[21], (L, D_B), 0.02),
        'w_out': nrm(ks[22], (L, D_MODEL, D_MODEL), DN_BETA * D_MODEL ** -0.5),
        'ln1_g': 1.0 + nrm(ks[23], (L, D_MODEL), 0.02),
        'ln1_b': nrm(ks[24], (L, D_MODEL), 0.02),
        'w_ff1': nrm(ks[25], (L, D_MODEL, D_FF), D_MODEL ** -0.5),
        'w_ff2': nrm(ks[26], (L, D_FF, D_MODEL), DN_BETA * D_FF ** -0.5),
        'ln2_g': 1.0 + nrm(ks[27], (L, D_MODEL), 0.02),
        'ln2_b': nrm(ks[28], (L, D_MODEL), 0.02),
    }


def reference(x_prompt, x_sample, state_conv_a, state_gdn, state_shift_b, state_wkv,
              w_in, conv_a_w, a_log, dt_bias, gdn_norm_g, mu_b, w0, w_up, a0, a_up, g_up,
              k_k, k_a, r_k, lnx_g, lnx_b, w_out, ln1_g, ln1_b, w_ff1, w_ff2, ln2_g, ln2_b):
    weights = (w_in, conv_a_w, a_log, dt_bias, gdn_norm_g, mu_b, w0, w_up, a0, a_up, g_up,
               k_k, k_a, r_k, lnx_g, lnx_b, w_out, ln1_g, ln1_b, w_ff1, w_ff2, ln2_g, ln2_b)
    bp, dtype = x_prompt.shape[0], x_prompt.dtype
    hp, hs = x_prompt, x_sample
    out_p, out_s = [], []
    for l in range(DEPTH):
        lw = tuple(wt[l] for wt in weights)
        hp, *st_p = _layer(hp,
                           jnp.zeros((bp, CONV_W - 1, CONV_CH), dtype),
                           jnp.zeros((bp, H_A, DK_A, DV_A), dtype),
                           jnp.zeros((bp, COLS_B), dtype),
                           jnp.zeros((bp, H_B, N_B, N_B), dtype),
                           *lw)
        hs, *st_s = _layer(hs, state_conv_a[l], state_gdn[l], state_shift_b[l], state_wkv[l], *lw)
        out_p.append(st_p)
        out_s.append(st_s)
    conv_p, gdn_p, shift_p, wkv_p = (jnp.stack([s[i] for s in out_p]) for i in range(4))
    conv_s, gdn_s, shift_s, wkv_s = (jnp.stack([s[i] for s in out_s]) for i in range(4))
    return (hp, hs, conv_p, gdn_p, shift_p, wkv_p, conv_s, gdn_s, shift_s, wkv_s)
```

```cpp
#include <hip/hip_runtime.h>
#include <hip/hip_cooperative_groups.h>
#include <cstdio>
namespace cg = cooperative_groups;
namespace pg8 {
#define PG8_LAS __attribute__((address_space(3)))
typedef unsigned short bf16_t;
typedef short bf16x8 __attribute__((ext_vector_type(8)));
typedef float f32x4 __attribute__((ext_vector_type(4)));
typedef unsigned u32x4 __attribute__((ext_vector_type(4)));
constexpr int BM = 256, BK = 64, HALF = 128, HTB = HALF * BK * 2  , STAGE_BYTES = 8 * HTB, NXCD = 8, WGM = 8;

__host__ __device__ __forceinline__ int lds_byte(int r, int c) { const int st = (r >> 4) * 2 + (c >> 5), rr = r & 15, cc = c & 31, ob = rr * 64 + cc * 2; return st * 1024 + (ob ^ (((ob >> 9) & 1) << 5)); }
__host__ __device__ __forceinline__ void stage_rc(int b, int& R, int& C) { const int st = b / 1024, sb = b % 1024, swz = sb ^ (((sb >> 9) & 1) << 5); R = (st >> 1) * 16 + swz / 64; C = (st & 1) * 32 + (swz % 64) / 2; }
__host__ __device__ __forceinline__ int perm32(int rho) { const int n = rho >> 4, i = rho & 15; return 8 * (i >> 2) + 4 * n + (i & 3); }

struct Unit { int pm, pn; };
struct Gemm { const bf16_t* A; const bf16_t* Bt; int M, N, K; };

struct StaticOrder {
    int nM, nN, nwg, G, c;
    __host__ __device__ void init(int M, int N, int G_, int c_) { nM = M / BM; nN = N / BM; nwg = nM * nN; G = G_; c = c_; }
    __host__ __device__ bool next(int i, Unit& u) const {
        const long L = (long)i * G + c; if (L >= nwg) return false;
        int wgid = (int)L; { const int q = nwg / NXCD, r = nwg % NXCD, xcd = wgid % NXCD, off = wgid / NXCD; wgid = (xcd < r ? xcd * (q + 1) : r * (q + 1) + (xcd - r) * q) + off; }
        const int nig = WGM * nN, gid = wgid / nig, fm = gid * WGM, gsz = (nM - fm) < WGM ? (nM - fm) : WGM;
        u.pm = fm + ((wgid % nig) % gsz); u.pn = (wgid % nig) / gsz; return true;
    }
    __device__ __forceinline__ void a_ready(const Unit&) const {}
    __device__ __forceinline__ void done(const Unit&) const {}
};
typedef float f32x2c __attribute__((ext_vector_type(2)));
typedef __bf16 bf16v2c __attribute__((ext_vector_type(2)));
__device__ __forceinline__ unsigned cvt_pk_bf16(float lo, float hi) { f32x2c f = {lo, hi}; bf16v2c v = __builtin_convertvector(f, bf16v2c); return __builtin_bit_cast(unsigned, v); }
template <class Epi, class Sched, bool STAMP = false>
__device__ __forceinline__ void gemm_phase(PG8_LAS unsigned char* lds, const Gemm g, const Sched& S, const Epi& E, unsigned long long* stamps) {
    int tid_l = threadIdx.x; asm volatile("" : "+v"(tid_l)); const int tid = tid_l, wid = __builtin_amdgcn_readfirstlane(tid >> 6), lane = tid & 63, wr = wid >> 2, wc = wid & 3, fr = lane & 15, fq = lane >> 4;
    const int K = g.K, nt = K / BK;
    int ts_lo = 0, ts_hi = 0, nts = 0; const unsigned long long rt_entry = STAMP ? (unsigned long long)wall_clock64() : 0ull;
#define PG8_STAMP() do { if (STAMP && wid == 0 && nts < 64) { const unsigned long long _c = (unsigned long long)clock64(); \
        ts_lo = (lane == nts) ? (int)(unsigned)_c : ts_lo; ts_hi = (lane == nts) ? (int)(unsigned)(_c >> 32) : ts_hi; ++nts; } } while (0)
    PG8_STAMP();
    unsigned voffA[2], voffB[2];
#pragma unroll
    for (int i = 0; i < 2; ++i) { int R, C; stage_rc(tid * 16 + i * 8192, R, C); const int Rb = Epi::PERM ? ((R & ~31) + perm32(R & 31)) : R;
        voffA[i] = (unsigned)(R * K + C) * 2u; voffB[i] = (unsigned)(Rb * K + C) * 2u; }
    const size_t kstep = (size_t)(BK * 2);
    const size_t hstep = (size_t)HALF * K * 2;
    const size_t tstep = 2 * hstep;
    const unsigned ldsw = (unsigned)wid * 1024u;
    const int aoff = lds_byte(wr * 64 + fr, fq * 8), boff = lds_byte(wc * 32 + fr, fq * 8);
#define PG8_SA(b, h) (((b) * 2 + (h)) * HTB)
#define PG8_SB(b, h) ((4 + (b) * 2 + (h)) * HTB)
#define PG8_STAGE(bufoff, gbase, voff) do { _Pragma("unroll") for (int _i = 0; _i < 2; ++_i) \
        __builtin_amdgcn_global_load_lds((const unsigned*)((const char*)(gbase) + (voff)[_i]), (PG8_LAS unsigned*)(lds + (bufoff) + ldsw + _i * 8192), 16, 0, 0); } while (0)
#define PG8_LDA(dst, b, h) do { _Pragma("unroll") for (int m = 0; m < 4; ++m) _Pragma("unroll") for (int k = 0; k < 2; ++k) dst[m][k] = *(const PG8_LAS bf16x8*)(lds + PG8_SA(b, h) + aoff + m * 2048 + k * 1024); } while (0)
#define PG8_LDB(dst, b, h) do { _Pragma("unroll") for (int n = 0; n < 2; ++n) _Pragma("unroll") for (int k = 0; k < 2; ++k) dst[n][k] = *(const PG8_LAS bf16x8*)(lds + PG8_SB(b, h) + boff + n * 2048 + k * 1024); } while (0)
#define PG8_MMA(ai, bj, At, Bt) do { __builtin_amdgcn_s_setprio(1); _Pragma("unroll") for (int m = 0; m < 4; ++m) _Pragma("unroll") for (int n = 0; n < 2; ++n) _Pragma("unroll") for (int k = 0; k < 2; ++k) \
        acc[ai][bj][m][n] = __builtin_amdgcn_mfma_f32_16x16x32_bf16(Bt[n][k], At[m][k], acc[ai][bj][m][n], 0, 0, 0); __builtin_amdgcn_s_setprio(0); } while (0)
#define PG8_WAIT_V(n) asm volatile("s_waitcnt vmcnt(" #n ")" ::: "memory")
#define PG8_WAIT_L(n) asm volatile("s_waitcnt lgkmcnt(" #n ")" ::: "memory")
#define PG8_BAR __builtin_amdgcn_s_barrier()
#define PG8_SCHED __builtin_amdgcn_sched_barrier(0)
    Unit cur, nxt; int ui = 0;
    if (!S.next(0, cur)) return;
    f32x4 acc[2][2][4][2];
#pragma unroll
    for (int a = 0; a < 2; ++a)
#pragma unroll
        for (int b = 0; b < 2; ++b)
#pragma unroll
            for (int m = 0; m < 4; ++m)
#pragma unroll
                for (int n = 0; n < 2; ++n) acc[a][b][m][n] = (f32x4){0.f, 0.f, 0.f, 0.f};
    bf16x8 At[4][2], B0[2][2], B1[2][2];
    const char* cA = (const char*)g.A + (size_t)cur.pm * tstep; const char* cB = (const char*)g.Bt + (size_t)cur.pn * tstep;
    S.a_ready(cur);
    PG8_STAGE(PG8_SB(0, 0), cB, voffB); PG8_STAGE(PG8_SA(0, 0), cA, voffA); PG8_STAGE(PG8_SB(0, 1), cB + hstep, voffB); PG8_STAGE(PG8_SA(0, 1), cA + hstep, voffA);
    if (wr == 1) PG8_BAR;
    PG8_WAIT_V(4); PG8_BAR;
    PG8_STAGE(PG8_SB(1, 0), cB + kstep, voffB); PG8_STAGE(PG8_SA(1, 0), cA + kstep, voffA); PG8_STAGE(PG8_SB(1, 1), cB + hstep + kstep, voffB);
    PG8_WAIT_V(6); PG8_BAR;
    PG8_STAMP();
    for (;;) {
        const bool has_next = S.next(ui + 1, nxt);
        const char* nA = has_next ? (const char*)g.A + (size_t)nxt.pm * tstep : cA; const char* nB = has_next ? (const char*)g.Bt + (size_t)nxt.pn * tstep : cB;
        for (int t = 0; t < nt; t += 2) {
            const bool last = (t == nt - 2);
            const char* a1 = cA + (size_t)(t + 1) * kstep;
            const char* a2 = last ? nA : cA + (size_t)(t + 2) * kstep; const char* b2 = last ? nB : cB + (size_t)(t + 2) * kstep;
            const char* a3 = a2 + kstep; const char* b3 = b2 + kstep;
            if (last && has_next) S.a_ready(nxt);
            PG8_LDB(B0, 0, 0); PG8_SCHED; PG8_LDA(At, 0, 0); PG8_STAGE(PG8_SA(1, 1), a1 + hstep, voffA);
            PG8_WAIT_L(8); PG8_BAR; PG8_WAIT_L(0); PG8_MMA(0, 0, At, B0); PG8_BAR; PG8_SCHED;
            PG8_LDB(B1, 0, 1); PG8_STAGE(PG8_SB(0, 0), b2, voffB);
            PG8_BAR; PG8_WAIT_L(0); PG8_MMA(0, 1, At, B1); PG8_BAR;
            PG8_LDA(At, 0, 1); PG8_STAGE(PG8_SA(0, 0), a2, voffA);
            PG8_BAR; PG8_WAIT_L(0); PG8_MMA(1, 0, At, B0); PG8_BAR; PG8_SCHED;
            PG8_STAGE(PG8_SB(0, 1), b2 + hstep, voffB);
            PG8_WAIT_V(6); PG8_BAR; PG8_MMA(1, 1, At, B1); PG8_BAR;
            PG8_LDB(B0, 1, 0); PG8_SCHED; PG8_LDA(At, 1, 0); PG8_STAGE(PG8_SA(0, 1), a2 + hstep, voffA);
            PG8_WAIT_L(8); PG8_BAR; PG8_WAIT_L(0); PG8_MMA(0, 0, At, B0); PG8_BAR; PG8_SCHED;
            PG8_LDB(B1, 1, 1); PG8_STAGE(PG8_SB(1, 0), b3, voffB);
            PG8_BAR; PG8_WAIT_L(0); PG8_MMA(0, 1, At, B1); PG8_BAR;
            PG8_LDA(At, 1, 1); PG8_STAGE(PG8_SA(1, 0), a3, voffA);
            PG8_BAR; PG8_WAIT_L(0); PG8_MMA(1, 0, At, B0); PG8_BAR; PG8_SCHED;
            PG8_STAGE(PG8_SB(1, 1), b3 + hstep, voffB);
            PG8_WAIT_V(6); PG8_BAR; PG8_MMA(1, 1, At, B1); PG8_BAR;
        }
        PG8_STAMP();
        if constexpr (!Epi::AFTER_DRAIN) { E(acc, cur, wr, wc, fr, fq); S.done(cur); }
        PG8_STAMP();
        if (!has_next) break;
#pragma unroll
        for (int a = 0; a < 2; ++a)
#pragma unroll
            for (int b = 0; b < 2; ++b)
#pragma unroll
                for (int m = 0; m < 4; ++m)
#pragma unroll
                    for (int n = 0; n < 2; ++n) acc[a][b][m][n] = (f32x4){0.f, 0.f, 0.f, 0.f};
        cur = nxt; cA = nA; cB = nB; ++ui;
    }
    PG8_WAIT_V(0);
    if (wr == 0) PG8_BAR;
    PG8_BAR;
    if constexpr (Epi::AFTER_DRAIN) { E.fused(acc, cur, wr, wc, fr, fq, lds, wid, lane); S.done(cur); }
    PG8_STAMP();
    if (STAMP && wid == 0) { stamps[lane] = lane < nts ? (((unsigned long long)(unsigned)ts_hi << 32) | (unsigned)ts_lo) : 0ull;
        if (lane == 62) stamps[62] = rt_entry; if (lane == 63) stamps[63] = (unsigned long long)wall_clock64(); }
#undef PG8_STAMP
#undef PG8_SA
#undef PG8_SB
#undef PG8_STAGE
#undef PG8_LDA
#undef PG8_LDB
#undef PG8_MMA
#undef PG8_WAIT_V
#undef PG8_WAIT_L
#undef PG8_BAR
#undef PG8_SCHED
}
}
using pg8::bf16_t; using pg8::bf16x8; using pg8::f32x4; using pg8::u32x4; using pg8::cvt_pk_bf16;
typedef float f32x2 __attribute__((ext_vector_type(2)));
typedef unsigned u32x2 __attribute__((ext_vector_type(2)));
#define LAS __attribute__((address_space(3)))
typedef LAS unsigned char* lds_t;

constexpr int D = 1024, NB = 32, SEQ = 2048, NSB = 8, NSS = 16;
constexpr int TS = 512, NSEG = SEQ / TS;
constexpr int MPR = NB * TS;
constexpr int MP = MPR + 256;
constexpr int NSAMP = NSB * NSS;
constexpr int NPAD = 9728, COLS = 9488;
constexpr int C_Z = 3072, C_BETA = 4096, C_AR = 4104, C_PB = 4112, C_GA = 7440, C_GB = 8464, CB = 3328;
constexpr float DN_ALPHA = 1.189207115002721f;
constexpr int LDS_BYTES = 163840;
constexpr int NITEM_P = NB * (TS / 64) * 8;
constexpr int NITEM = NITEM_P + 64;

constexpr size_t O_YP = 0, O_YS = O_YP + (size_t)NB * SEQ * D, O_CP = O_YS + (size_t)NSAMP * D, O_GP = O_CP + (size_t)NB * 3 * 3072,
    O_SP = O_GP + (size_t)NB * 8 * 16384, O_WP = O_SP + (size_t)NB * CB, O_CS = O_WP + (size_t)NB * 16 * 4096, O_GS = O_CS + (size_t)NSB * 3 * 3072,
    O_SS = O_GS + (size_t)NSB * 8 * 16384, O_WS = O_SS + (size_t)NSB * CB;
constexpr size_t al256(size_t x) { return (x + 255) & ~(size_t)255; }
constexpr size_t W_WIN = 0, W_WLORA = W_WIN + al256((size_t)NPAD * 1024 * 2), W_WOUT = W_WLORA + al256((size_t)3072 * 256 * 2), W_WFF1 = W_WOUT + al256((size_t)1024 * 1024 * 2),
    W_WFF2 = W_WFF1 + al256((size_t)4096 * 1024 * 2), W_XB = W_WFF2 + al256((size_t)4096 * 1024 * 2), W_P = W_XB + al256((size_t)MP * 1024 * 2), W_QKV = W_P + al256((size_t)MP * NPAD * 2),
    W_BG = W_QKV + al256((size_t)MP * 3072 * 2), W_LA = W_BG + al256((size_t)MP * 16 * 4), W_L = W_LA + al256((size_t)MP * 256 * 2), W_T = W_L + al256((size_t)MP * 3072 * 2),
    W_GC = W_T + al256((size_t)NITEM * 8192 * 2), W_MG = W_GC + al256((size_t)NITEM * 64 * 4), W_PL = W_MG + al256((size_t)MP * 1024 * 2), W_CC = W_PL + al256((size_t)MP * 1024 * 4),
    W_SC = W_CC + al256((size_t)2 * NB * 3 * 3072 * 2), W_END = W_SC + al256((size_t)2 * NB * CB * 2);

struct Params { const float* in[29]; float* out; unsigned char* ws; int ph_lo, ph_hi; };

__device__ __forceinline__ int ltid() { int t = threadIdx.x; asm volatile("" : "+v"(t)); return t; }
__device__ __forceinline__ float bf2f(unsigned v) { return __uint_as_float(v << 16); }
__device__ __forceinline__ float bflo(unsigned v) { return __uint_as_float(v << 16); }
__device__ __forceinline__ float bfhi(unsigned v) { return __uint_as_float(v & 0xffff0000u); }
__device__ __forceinline__ bf16_t f2bf(float f) { return (bf16_t)(cvt_pk_bf16(f, 0.f) & 0xffffu); }
__device__ __forceinline__ float sigm(float x) { return 1.0f / (1.0f + __expf(-x)); }
__device__ __forceinline__ float siluf(float x) { return x * sigm(x); }
__device__ __forceinline__ float softplusf(float x) { return x > 20.f ? x : log1pf(__expf(x)); }
__device__ __forceinline__ float wave_sum(float v) {
#pragma unroll
    for (int o = 1; o < 64; o <<= 1) v += __shfl_xor(v, o);
    return v;
}
template <int CTRL> __device__ __forceinline__ float dppmov(float v) { return __int_as_float(__builtin_amdgcn_update_dpp(0, __float_as_int(v), CTRL, 0xf, 0xf, true)); }
__device__ __forceinline__ float reduce8(float v) { v += dppmov<0xB1>(v); v += dppmov<0x4E>(v); v += dppmov<0x141>(v); return v; }
__device__ __forceinline__ f32x4 mfma16(bf16x8 a, bf16x8 b, f32x4 c) { return __builtin_amdgcn_mfma_f32_16x16x32_bf16(a, b, c, 0, 0, 0); }

__device__ __forceinline__ const float* xrow_ptr(const Params& p, int r, int s) {
    if (r < MPR) { const int b = r / TS, tt = r % TS; return p.in[0] + ((size_t)(b * SEQ + s * TS + tt)) * D; }
    if (s == 0 && r < MPR + NSAMP) return p.in[1] + (size_t)(r - MPR) * D;
    return nullptr;
}
__device__ __forceinline__ float* yrow_ptr(const Params& p, int r, int s) {
    if (r < MPR) { const int b = r / TS, tt = r % TS; return p.out + O_YP + ((size_t)(b * SEQ + s * TS + tt)) * D; }
    return p.out + O_YS + (size_t)(r - MPR) * D;
}

template <int ACT> struct EpiB16 {
    static constexpr bool PERM = true, AFTER_DRAIN = false;
    bf16_t* O; int ldc;
    __device__ __forceinline__ void operator()(const f32x4 (&acc)[2][2][4][2], const pg8::Unit& u, int wr, int wc, int fr, int fq) const {
        const int row0 = u.pm * 256 + wr * 64 + fr, col0 = u.pn * 256 + wc * 32 + 8 * fq;
#pragma unroll
        for (int ai = 0; ai < 2; ++ai)
#pragma unroll
            for (int m = 0; m < 4; ++m) { bf16_t* rowp = O + (size_t)(row0 + ai * 128 + m * 16) * ldc + col0;
#pragma unroll
                for (int bj = 0; bj < 2; ++bj) { f32x4 v0 = acc[ai][bj][m][0], v1 = acc[ai][bj][m][1];
                    if (ACT == 1) {
#pragma unroll
                        for (int j = 0; j < 4; ++j) { const float a = fmaxf(v0[j], 0.f), b = fmaxf(v1[j], 0.f); v0[j] = a * a; v1[j] = b * b; } }
                    u32x4 w; w.x = cvt_pk_bf16(v0[0], v0[1]); w.y = cvt_pk_bf16(v0[2], v0[3]); w.z = cvt_pk_bf16(v1[0], v1[1]); w.w = cvt_pk_bf16(v1[2], v1[3]);
                    *(u32x4*)(rowp + bj * 128) = w; } }
    }
};
struct EpiAdd {
    static constexpr bool PERM = false, AFTER_DRAIN = false;
    float* C; const float* xp; const float* xs; int s; int mode;
    __device__ __forceinline__ void operator()(const f32x4 (&acc)[2][2][4][2], const pg8::Unit& u, int wr, int wc, int fr, int fq) const {
        const int row0 = u.pm * 256 + wr * 64 + fr, col0 = u.pn * 256 + wc * 32 + 4 * fq;
#pragma unroll
        for (int ai = 0; ai < 2; ++ai)
#pragma unroll
            for (int m = 0; m < 4; ++m) { const int row = row0 + ai * 128 + m * 16; float* rowp = C + (size_t)row * 1024 + col0;
                const float* bp;
                if (mode) bp = rowp;
                else { if (row < MPR) { const int b = row / TS, tt = row % TS; bp = xp + ((size_t)(b * SEQ + s * TS + tt)) * D + col0; }
                       else if (s == 0 && row < MPR + NSAMP) bp = xs + (size_t)(row - MPR) * D + col0; else bp = nullptr; }
#pragma unroll
                for (int bj = 0; bj < 2; ++bj)
#pragma unroll
                    for (int n = 0; n < 2; ++n) { f32x4 bs = (f32x4){0.f, 0.f, 0.f, 0.f}; if (bp) bs = *(const f32x4*)(bp + bj * 128 + n * 16);
                        *(f32x4*)(rowp + bj * 128 + n * 16) = acc[ai][bj][m][n] + DN_ALPHA * bs; }
                asm volatile("" ::: "memory"); }
    }
};
__device__ __forceinline__ void ph_wprep(const Params& p, lds_t L) {
    LAS float* tile = (LAS float*)L;
    const int tid = ltid();
    for (int it = blockIdx.x; it < 4736; it += gridDim.x) {
        const float* W; bf16_t* WT; int K, N, NP_; int r = it;
        if (r < 2432) { W = p.in[6]; WT = (bf16_t*)(p.ws + W_WIN); K = 1024; N = COLS; NP_ = NPAD; }
        else if ((r -= 2432) < 256) { W = p.in[22]; WT = (bf16_t*)(p.ws + W_WOUT); K = 1024; N = 1024; NP_ = 1024; }
        else if ((r -= 256) < 1024) { W = p.in[25]; WT = (bf16_t*)(p.ws + W_WFF1); K = 1024; N = 4096; NP_ = 4096; }
        else { r -= 1024; W = p.in[26]; WT = (bf16_t*)(p.ws + W_WFF2); K = 4096; N = 1024; NP_ = 1024; }
        const int ntl = NP_ / 64, k0 = (r / ntl) * 64, n0 = (r % ntl) * 64;
        { const int j = tid & 63, i0 = tid >> 6;
#pragma unroll
          for (int q = 0; q < 8; ++q) { const int i = i0 + 8 * q; tile[i * 65 + j] = (n0 + j < N) ? W[(size_t)(k0 + i) * N + n0 + j] : 0.f; } }
        __syncthreads();
        { const int k2 = (tid & 31) * 2, nn = tid >> 5;
#pragma unroll
          for (int q = 0; q < 4; ++q) { const int n = nn + 16 * q; *(unsigned*)(WT + (size_t)(n0 + n) * K + k0 + k2) = cvt_pk_bf16(tile[k2 * 65 + n], tile[(k2 + 1) * 65 + n]); } }
        __syncthreads();
    }
    bf16_t* WL = (bf16_t*)(p.ws + W_WLORA);
    for (int idx = blockIdx.x * 512 + tid; idx < 3072 * 256; idx += gridDim.x * 512) {
        const int n = idx >> 8, k = idx & 255; float v = 0.f;
        if (n < 1024) { if (k < 64) v = p.in[13][k * 1024 + n]; }
        else if (n < 2048) { if (k >= 64 && k < 128) v = p.in[15][(k - 64) * 1024 + n - 1024]; }
        else { if (k >= 128) v = p.in[16][(k - 128) * 1024 + n - 2048]; }
        WL[idx] = f2bf(v);
    }
}
__device__ __forceinline__ void ph_cvt(const Params& p, int s) {
    bf16_t* xb = (bf16_t*)(p.ws + W_XB);
    const int tid = ltid(), mps = (s == 0) ? MP : MPR;
    for (int r4 = blockIdx.x; r4 < mps / 4; r4 += gridDim.x) {
        const int r = r4 * 4 + (tid >> 7), c = (tid & 127) * 8;
        const float* src = xrow_ptr(p, r, s);
        f32x4 a = (f32x4){0.f, 0.f, 0.f, 0.f}, b = a;
        if (src) { a = *(const f32x4*)(src + c); b = *(const f32x4*)(src + c + 4); }
        u32x4 o; o.x = cvt_pk_bf16(a[0], a[1]); o.y = cvt_pk_bf16(a[2], a[3]); o.z = cvt_pk_bf16(b[0], b[1]); o.w = cvt_pk_bf16(b[2], b[3]);
        *(u32x4*)(xb + (size_t)r * 1024 + c) = o;
    }
}
__device__ __forceinline__ void ph_prep(const Params& p, int s) {
    const bf16_t* P = (const bf16_t*)(p.ws + W_P);
    bf16_t* QKV = (bf16_t*)(p.ws + W_QKV); float* BG = (float*)(p.ws + W_BG); bf16_t* LA = (bf16_t*)(p.ws + W_LA);
    bf16_t* CC = (bf16_t*)(p.ws + W_CC); bf16_t* SC = (bf16_t*)(p.ws + W_SC);
    const int tid = ltid();
    const int ngr = ((s == 0) ? (MPR + NSAMP) : MPR) / 4;
    const float* cw = p.in[7];
    for (int g = blockIdx.x; g < ngr; g += gridDim.x) {
        const int r0 = g * 4; const bool samp = r0 >= MPR;
        const int b = samp ? (r0 - MPR) / NSS : r0 / TS, tt0 = samp ? (r0 - MPR) % NSS : r0 % TS, tlen = samp ? NSS : TS;
        const bool lastg = (tt0 == tlen - 4);
#pragma unroll
        for (int sec = 0; sec < 3; ++sec) {
            const int ch = sec * 1024 + 2 * tid;
            float x0[7], x1[7]; unsigned raw[7];
#pragma unroll
            for (int q = 0; q < 7; ++q) {
                if (q >= 3 || tt0 > 0) { raw[q] = *(const unsigned*)(P + (size_t)(r0 - 3 + q) * NPAD + ch); x0[q] = bflo(raw[q]); x1[q] = bfhi(raw[q]); }
                else if (samp) { const float* sp = p.in[2] + ((size_t)(b * 3 + q)) * 3072 + ch; x0[q] = sp[0]; x1[q] = sp[1]; raw[q] = 0; }
                else if (s > 0) { raw[q] = *(const unsigned*)(CC + ((size_t)((s & 1) * NB + b) * 3 + q) * 3072 + ch); x0[q] = bflo(raw[q]); x1[q] = bfhi(raw[q]); }
                else { x0[q] = 0.f; x1[q] = 0.f; raw[q] = 0; }
            }
            float w0[4], w1[4];
#pragma unroll
            for (int j = 0; j < 4; ++j) { w0[j] = cw[j * 3072 + ch]; w1[j] = cw[j * 3072 + ch + 1]; }
#pragma unroll
            for (int j = 0; j < 4; ++j) {
                float y0 = 0.f, y1 = 0.f;
#pragma unroll
                for (int t = 0; t < 4; ++t) { y0 += w0[t] * x0[j + t]; y1 += w1[t] * x1[j + t]; }
                y0 = siluf(y0); y1 = siluf(y1);
                if (sec < 2) { const float ss = wave_sum(y0 * y0 + y1 * y1); float rn = rsqrtf(ss + 1e-6f); if (sec == 0) rn *= 0.08838834764831845f; y0 *= rn; y1 *= rn; }
                *(unsigned*)(QKV + (size_t)(r0 + j) * 3072 + ch) = cvt_pk_bf16(y0, y1);
            }
            if (lastg) {
#pragma unroll
                for (int j = 1; j < 4; ++j) {
                    if (!samp) { *(unsigned*)(CC + ((size_t)(((s + 1) & 1) * NB + b) * 3 + (j - 1)) * 3072 + ch) = raw[j + 3];
                        if (s == NSEG - 1) { float* o = p.out + O_CP + ((size_t)(b * 3 + j - 1)) * 3072 + ch; o[0] = x0[j + 3]; o[1] = x1[j + 3]; } }
                    else { float* o = p.out + O_CS + ((size_t)(b * 3 + j - 1)) * 3072 + ch; o[0] = x0[j + 3]; o[1] = x1[j + 3]; }
                }
            }
        }
        if (tid < 32) { const int j = tid >> 3, h = tid & 7; const bf16_t* Pr = P + (size_t)(r0 + j) * NPAD;
            const float br = bf2f(Pr[C_BETA + h]), ar = bf2f(Pr[C_AR + h]);
            BG[(size_t)(r0 + j) * 16 + h] = sigm(br); BG[(size_t)(r0 + j) * 16 + 8 + h] = -__expf(p.in[8][h]) * softplusf(ar + p.in[9][h]); }
#pragma unroll
        for (int e = 0; e < 2; ++e) { const int item = tid + 512 * e, j = item >> 8, c = item & 255, col = 3072 + c;
            const float pv = bf2f(P[(size_t)(r0 + j) * NPAD + C_PB + col]); float prev;
            if (tt0 + j > 0) prev = bf2f(P[(size_t)(r0 + j - 1) * NPAD + C_PB + col]);
            else if (samp) prev = p.in[4][(size_t)b * CB + col];
            else if (s > 0) prev = bf2f(SC[((size_t)((s & 1) * NB + b)) * CB + col]);
            else prev = 0.f;
            const float xs = pv + p.in[11][col] * (prev - pv);
            const float v = (c < 64) ? tanhf(xs) : ((c < 128) ? xs : sigm(xs));
            LA[(size_t)(r0 + j) * 256 + c] = f2bf(v); }
        if (lastg) { const bf16_t* Pr = P + (size_t)(r0 + 3) * NPAD + C_PB;
            for (int c = tid; c < CB; c += 512) { const bf16_t v = Pr[c];
                if (!samp) { SC[((size_t)(((s + 1) & 1) * NB + b)) * CB + c] = v; if (s == NSEG - 1) p.out[O_SP + (size_t)b * CB + c] = bf2f(v); }
                else p.out[O_SS + (size_t)b * CB + c] = bf2f(v); } }
    }
}
template <int WHICH> __device__ __forceinline__ void ph_ln(const Params& p, int s) {
    float* PL = (float*)(p.ws + W_PL); bf16_t* hb = (bf16_t*)(p.ws + W_XB);
    const int tidl = ltid(); const int lane = tidl & 63, wave = tidl >> 6, nv = (s == 0) ? (MPR + NSAMP) : MPR;
    const float* gg = p.in[WHICH == 0 ? 23 : 27]; const float* bb = p.in[WHICH == 0 ? 24 : 28];
    f32x4 gv[4], bv[4];
#pragma unroll
    for (int j = 0; j < 4; ++j) { gv[j] = *(const f32x4*)(gg + (lane + 64 * j) * 4); bv[j] = *(const f32x4*)(bb + (lane + 64 * j) * 4); }
    for (int r = blockIdx.x * 8 + wave; r < nv; r += gridDim.x * 8) {
        float* xr = PL + (size_t)r * 1024;
        f32x4 v[4]; float sm = 0.f;
#pragma unroll
        for (int j = 0; j < 4; ++j) { v[j] = *(const f32x4*)(xr + (lane + 64 * j) * 4); sm += (v[j][0] + v[j][1]) + (v[j][2] + v[j][3]); }
        const float mean = wave_sum(sm) * (1.f / 1024.f); float s2 = 0.f;
#pragma unroll
        for (int j = 0; j < 4; ++j) { v[j] = v[j] - mean; s2 += (v[j][0] * v[j][0] + v[j][1] * v[j][1]) + (v[j][2] * v[j][2] + v[j][3] * v[j][3]); }
        const float rstd = rsqrtf(wave_sum(s2) * (1.f / 1024.f) + 1e-5f);
        float* yo = (WHICH == 0) ? xr : yrow_ptr(p, r, s);
#pragma unroll
        for (int j = 0; j < 4; ++j) { const f32x4 o = v[j] * rstd * gv[j] + bv[j]; *(f32x4*)(yo + (lane + 64 * j) * 4) = o;
            if (WHICH == 0) { u32x2 w; w.x = cvt_pk_bf16(o[0], o[1]); w.y = cvt_pk_bf16(o[2], o[3]); *(u32x2*)(hb + (size_t)r * 1024 + (lane + 64 * j) * 4) = w; } }
    }
}
__device__ __forceinline__ void ph_gdnpre(const Params& p, lds_t L, int s) {
    const bf16_t* QKV = (const bf16_t*)(p.ws + W_QKV); const float* BG = (const float*)(p.ws + W_BG);
    bf16_t* Tm = (bf16_t*)(p.ws + W_T); float* GC = (float*)(p.ws + W_GC);
    const int tidl = ltid(); const int lane = tidl & 63, wave = tidl >> 6, l15 = lane & 15, lq = lane >> 4;
    LAS float* Af = (LAS float*)(L + wave * 16896); LAS float* gcs = Af + 4096; LAS float* bts = gcs + 64;
    const int ni = (s == 0) ? NITEM : NITEM_P;
    for (int it = blockIdx.x * 8 + wave; it < ni; it += gridDim.x * 8) {
        int row0, h, nvalid;
        if (it < NITEM_P) { const int b = it >> 6, ck = (it >> 3) & 7; h = it & 7; row0 = b * TS + ck * 64; nvalid = 64; }
        else { const int j = it - NITEM_P; h = j & 7; row0 = MPR + (j >> 3) * NSS; nvalid = NSS; }
        float g = 0.f, bt = 0.f;
        if (lane < nvalid) { g = BG[(size_t)(row0 + lane) * 16 + 8 + h]; bt = BG[(size_t)(row0 + lane) * 16 + h]; }
#pragma unroll
        for (int o = 1; o < 64; o <<= 1) { const float t = __shfl_up(g, o); if (lane >= o) g += t; }
        gcs[lane] = g; bts[lane] = bt;
        f32x4 acc[4][4];
#pragma unroll
        for (int I = 0; I < 4; ++I)
#pragma unroll
            for (int J = 0; J < 4; ++J) acc[I][J] = (f32x4){0.f, 0.f, 0.f, 0.f};
#pragma unroll
        for (int kk = 0; kk < 4; ++kk) {
            bf16x8 fr[4];
#pragma unroll
            for (int I = 0; I < 4; ++I) { const int row = 16 * I + l15; u32x4 v = (u32x4){0u, 0u, 0u, 0u};
                if (row < nvalid) v = *(const u32x4*)(QKV + (size_t)(row0 + row) * 3072 + 1024 + h * 128 + kk * 32 + 8 * lq);
                fr[I] = __builtin_bit_cast(bf16x8, v); }
#pragma unroll
            for (int I = 0; I < 4; ++I)
#pragma unroll
                for (int J = 0; J <= I; ++J) acc[I][J] = mfma16(fr[I], fr[J], acc[I][J]);
            asm volatile("" ::: "memory");
        }
        asm volatile("s_waitcnt lgkmcnt(0)" ::: "memory");
#pragma unroll
        for (int I = 0; I < 4; ++I)
#pragma unroll
            for (int J = 0; J < 4; ++J)
#pragma unroll
                for (int jj = 0; jj < 4; ++jj) { const int i = 16 * I + 4 * lq + jj, j = 16 * J + l15;
                    float val = 0.f; if (J <= I && i > j) val = bts[i] * acc[I][J][jj] * __expf(gcs[i] - gcs[j]);
                    Af[i * 64 + j] = val; }
        asm volatile("s_waitcnt lgkmcnt(0)" ::: "memory");
        float t[64];
        int ll = lane; asm volatile("" : "+v"(ll));
#pragma unroll
        for (int i = 0; i < 64; ++i) {
            float a0 = (ll == i) ? 1.f : 0.f, a1 = 0.f;
#pragma unroll
            for (int j4 = 0; j4 < i; j4 += 4) { const f32x4 av = *(const LAS f32x4*)(Af + i * 64 + j4);
                a0 -= av[0] * t[j4]; if (j4 + 1 < i) a1 -= av[1] * t[j4 + 1]; if (j4 + 2 < i) a0 -= av[2] * t[j4 + 2]; if (j4 + 3 < i) a1 -= av[3] * t[j4 + 3]; }
            t[i] = a0 + a1;
            asm volatile("" ::: "memory");
        }
        const float sb = bts[lane], sg = sb * __expf(gcs[lane]);
        const float gcl = gcs[lane];
        asm volatile("s_waitcnt lgkmcnt(0)" ::: "memory");
        LAS bf16_t* TL = (LAS bf16_t*)Af;
#pragma unroll
        for (int i = 0; i < 64; ++i) { TL[i * 64 + lane] = f2bf(t[i] * sb); TL[4096 + i * 64 + lane] = f2bf(t[i] * sg); if ((i & 3) == 3) asm volatile("" ::: "memory"); }
        asm volatile("s_waitcnt lgkmcnt(0)" ::: "memory");
        bf16_t* Tb = Tm + (size_t)it * 8192;
#pragma unroll
        for (int q = 0; q < 16; ++q) *(u32x4*)(Tb + (size_t)(lane + 64 * q) * 8) = *(const LAS u32x4*)(TL + (lane + 64 * q) * 8);
        GC[(size_t)it * 64 + lane] = gcl;
        asm volatile("s_waitcnt lgkmcnt(0)" ::: "memory");
    }
}

constexpr int G_QH = 0, G_KH = 17408, G_KT = 34816, G_VT = 53248, G_VS = 71680, G_TB = 90112, G_TG = 99328, G_QK = 108544, G_SB = 117760, G_SM = 152576;
__device__ __forceinline__ int tofs(int r, int c) { return (r * 72 + c) * 2; }
#define LFRAG(off) (*(const LAS bf16x8*)(L + (off)))
__device__ __forceinline__ void gdn_seq(const Params& p, lds_t L, int row0, int nchunks, int nvalid, int item0, int h, const float* Sin, float* Sout) {
    const bf16_t* P = (const bf16_t*)(p.ws + W_P); const bf16_t* QKV = (const bf16_t*)(p.ws + W_QKV);
    const bf16_t* Tm = (const bf16_t*)(p.ws + W_T); const float* GC = (const float*)(p.ws + W_GC); bf16_t* MG = (bf16_t*)(p.ws + W_MG);
    const int tid = ltid(), lane = tid & 63, wave = tid >> 6, l15 = lane & 15, lq = lane >> 4;
    LAS float* SM = (LAS float*)(L + G_SM);
    f32x4 accS[8];
#pragma unroll
    for (int kt = 0; kt < 8; ++kt) { accS[kt] = (f32x4){0.f, 0.f, 0.f, 0.f}; if (Sin) accS[kt] = *(const f32x4*)(Sin + (size_t)(16 * kt + l15) * 128 + 16 * wave + 4 * lq); }
    const float ng0 = p.in[10][2 * lane], ng1 = p.in[10][2 * lane + 1];
    for (int ck = 0; ck < nchunks; ++ck) {
        const int r0 = row0 + ck * 64, item = item0 + ck * 8;
        int tl_ = tid; asm volatile("" : "+v"(tl_));
        const int lane = tl_ & 63, wave = tl_ >> 6, l15 = lane & 15, lq = lane >> 4;
#pragma unroll
        for (int e = 0; e < 2; ++e) {
            const int row = lane, c8 = (wave * 2 + e) * 8;
            u32x4 q = (u32x4){0u, 0u, 0u, 0u}, k = q, v = q;
            if (row < nvalid) { const bf16_t* src = QKV + (size_t)(r0 + row) * 3072 + h * 128 + c8; q = *(const u32x4*)src; k = *(const u32x4*)(src + 1024); v = *(const u32x4*)(src + 2048); }
            *(LAS u32x4*)(L + G_QH + (row * 136 + c8) * 2) = q;
            *(LAS u32x4*)(L + G_KH + (row * 136 + c8) * 2) = k;
#pragma unroll
            for (int x = 0; x < 4; ++x) {
                *(LAS bf16_t*)(L + G_KT + tofs(c8 + 2 * x, row)) = (bf16_t)(k[x] & 0xffffu); *(LAS bf16_t*)(L + G_KT + tofs(c8 + 2 * x + 1, row)) = (bf16_t)(k[x] >> 16);
                *(LAS bf16_t*)(L + G_VT + tofs(c8 + 2 * x, row)) = (bf16_t)(v[x] & 0xffffu); *(LAS bf16_t*)(L + G_VT + tofs(c8 + 2 * x + 1, row)) = (bf16_t)(v[x] >> 16);
            }
        }
        { const int row = tid >> 3, c8 = (tid & 7) * 8; const bf16_t* src = Tm + (size_t)item * 8192 + row * 64 + c8;
          *(LAS u32x4*)(L + G_TB + (row * 72 + c8) * 2) = *(const u32x4*)src; *(LAS u32x4*)(L + G_TG + (row * 72 + c8) * 2) = *(const u32x4*)(src + 4096); }
        if (tid < 64) { const float gcv = GC[(size_t)item * 64 + tid], gl = GC[(size_t)item * 64 + 63];
            SM[tid] = gcv; SM[64 + tid] = __expf(gcv); SM[128 + tid] = __expf(gl - gcv); if (tid == 0) SM[192] = __expf(gl); }
        if (ck == 0) {
#pragma unroll
            for (int kt = 0; kt < 8; ++kt)
#pragma unroll
                for (int jj = 0; jj < 4; ++jj) *(LAS bf16_t*)(L + G_SB + ((16 * wave + 4 * lq + jj) * 136 + 16 * kt + l15) * 2) = f2bf(accS[kt][jj]);
        }
        __syncthreads();
        {
            const int tI = wave >> 1;
#pragma unroll
            for (int x = 0; x < 2; ++x) { const int tJ = 2 * (wave & 1) + x; f32x4 a = (f32x4){0.f, 0.f, 0.f, 0.f};
                if (tJ <= tI) {
#pragma unroll
                    for (int kk = 0; kk < 4; ++kk) a = mfma16(LFRAG(G_QH + ((16 * tI + l15) * 136 + kk * 32 + 8 * lq) * 2), LFRAG(G_KH + ((16 * tJ + l15) * 136 + kk * 32 + 8 * lq) * 2), a); }
#pragma unroll
                for (int jj = 0; jj < 4; ++jj) { const int i = 16 * tI + 4 * lq + jj, j = 16 * tJ + l15;
                    const float val = (i >= j) ? a[jj] * __expf(SM[i] - SM[j]) : 0.f;
                    *(LAS bf16_t*)(L + G_QK + (i * 72 + j) * 2) = f2bf(val); } }
        }
        f32x4 accU[4], accW[4];
#pragma unroll
        for (int ct = 0; ct < 4; ++ct) { accU[ct] = (f32x4){0.f, 0.f, 0.f, 0.f}; accW[ct] = accU[ct];
#pragma unroll
            for (int js = 0; js < 2; ++js) {
                accU[ct] = mfma16(LFRAG(G_VT + tofs(16 * wave + l15, js * 32 + 8 * lq)), LFRAG(G_TB + ((16 * ct + l15) * 72 + js * 32 + 8 * lq) * 2), accU[ct]);
                accW[ct] = mfma16(LFRAG(G_TG + ((16 * ct + l15) * 72 + js * 32 + 8 * lq) * 2), LFRAG(G_KT + tofs(16 * wave + l15, js * 32 + 8 * lq)), accW[ct]); }
            asm volatile("" ::: "memory"); }
        __syncthreads();
#pragma unroll
        for (int ct = 0; ct < 4; ++ct)
#pragma unroll
            for (int jj = 0; jj < 4; ++jj) *(LAS bf16_t*)(L + G_KH + ((16 * ct + 4 * lq + jj) * 136 + 16 * wave + l15) * 2) = f2bf(-accW[ct][jj]);
        __syncthreads();
        f32x4 accO[4];
        {
            bf16x8 sf[4];
#pragma unroll
            for (int ks = 0; ks < 4; ++ks) sf[ks] = LFRAG(G_SB + ((16 * wave + l15) * 136 + ks * 32 + 8 * lq) * 2);
#pragma unroll
            for (int ct = 0; ct < 4; ++ct) { accO[ct] = (f32x4){0.f, 0.f, 0.f, 0.f};
#pragma unroll
                for (int ks = 0; ks < 4; ++ks) {
                    accU[ct] = mfma16(sf[ks], LFRAG(G_KH + ((16 * ct + l15) * 136 + ks * 32 + 8 * lq) * 2), accU[ct]);
                    accO[ct] = mfma16(sf[ks], LFRAG(G_QH + ((16 * ct + l15) * 136 + ks * 32 + 8 * lq) * 2), accO[ct]); }
                const int c = 16 * ct + l15; const float ec = SM[128 + c], eg = SM[64 + c];
#pragma unroll
                for (int jj = 0; jj < 4; ++jj) { const int v = 16 * wave + 4 * lq + jj;
                    *(LAS bf16_t*)(L + G_VT + tofs(v, c)) = f2bf(accU[ct][jj]); *(LAS bf16_t*)(L + G_VS + tofs(v, c)) = f2bf(accU[ct][jj] * ec);
                    accO[ct][jj] *= eg; }
                asm volatile("" ::: "memory"); }
        }
        __syncthreads();
        {
            bf16x8 vf[2], vsf[2];
#pragma unroll
            for (int js = 0; js < 2; ++js) { vf[js] = LFRAG(G_VT + tofs(16 * wave + l15, js * 32 + 8 * lq)); vsf[js] = LFRAG(G_VS + tofs(16 * wave + l15, js * 32 + 8 * lq)); }
#pragma unroll
            for (int ct = 0; ct < 4; ++ct) {
#pragma unroll
                for (int js = 0; js < 2; ++js) accO[ct] = mfma16(vf[js], LFRAG(G_QK + ((16 * ct + l15) * 72 + js * 32 + 8 * lq) * 2), accO[ct]);
                *(LAS f32x4*)(L + ((16 * ct + l15) * 132 + 16 * wave + 4 * lq) * 4) = accO[ct];
                asm volatile("" ::: "memory"); }
            const float egl = SM[192];
#pragma unroll
            for (int kt = 0; kt < 8; ++kt) { accS[kt] = accS[kt] * egl;
#pragma unroll
                for (int js = 0; js < 2; ++js) accS[kt] = mfma16(vsf[js], LFRAG(G_KT + tofs(16 * kt + l15, js * 32 + 8 * lq)), accS[kt]);
#pragma unroll
                for (int jj = 0; jj < 4; ++jj) *(LAS bf16_t*)(L + G_SB + ((16 * wave + 4 * lq + jj) * 136 + 16 * kt + l15) * 2) = f2bf(accS[kt][jj]);
                asm volatile("" ::: "memory"); }
        }
        __syncthreads();
#pragma unroll
        for (int q = 0; q < 8; ++q) { const int c = wave + 8 * q;
            if (c < nvalid) {
                const f32x2 o = *(const LAS f32x2*)(L + (c * 132 + 2 * lane) * 4);
                const float ss = wave_sum(o[0] * o[0] + o[1] * o[1]); const float rinv = rsqrtf(ss * (1.f / 128.f) + 1e-6f);
                const size_t row = (size_t)(r0 + c); const int col = h * 128 + 2 * lane;
                const unsigned zz = *(const unsigned*)(P + row * NPAD + C_Z + col), ga = *(const unsigned*)(P + row * NPAD + C_GA + col);
                const float o0 = o[0] * rinv * ng0 * siluf(bflo(zz)) * sigm(bflo(ga)), o1 = o[1] * rinv * ng1 * siluf(bfhi(zz)) * sigm(bfhi(ga));
                *(unsigned*)(MG + row * 1024 + col) = cvt_pk_bf16(o0, o1); } }
        __syncthreads();
    }
    { int so = l15 * 128 + 16 * wave + 4 * lq; asm volatile("" : "+v"(so));
#pragma unroll
      for (int kt = 0; kt < 8; ++kt) *(f32x4*)(Sout + (size_t)(so + kt * 2048)) = accS[kt]; }
}
constexpr int R_OP = 57344, R_YB = 114688;
__device__ __forceinline__ void rwkv_seq(const Params& p, lds_t L, int s, int rbase, int T, bool samp, int b, int h, const float* Sin, float* Sout) {
    const bf16_t* P = (const bf16_t*)(p.ws + W_P); const bf16_t* LR = (const bf16_t*)(p.ws + W_L); bf16_t* MG = (bf16_t*)(p.ws + W_MG);
    const bf16_t* SC = (const bf16_t*)(p.ws + W_SC);
    const int tid = ltid(), lane = tid & 63, wave = tid >> 6;
    const int NT = (T + 15) / 16;
    const bool scanner = wave < 4;
    const int hh_s = wave >> 1, half = wave & 1, rg = lane >> 3, jg = lane & 7, i0 = 32 * half + 4 * rg, j0 = 8 * jg;
    f32x2 S[4][4];
    const int lw = wave - 4, hh_l = (lw >> 1) & 1, st0 = 8 * (lw & 1);
    const int hg = 2 * h + (scanner ? hh_s : hh_l);
    const int hc = hg * 64 + lane;
    float c_mur = 0.f, c_muk = 0.f, c_muv = 0.f, c_w0 = 0.f, c_a0 = 0.f, c_kk = 0.f, c_ka = 0.f, c_rk = 0.f, c_lg = 0.f, c_lb = 0.f, c_pr = 0.f, c_pk = 0.f, c_pv = 0.f;
    if (scanner) {
#pragma unroll
        for (int ii = 0; ii < 4; ++ii)
#pragma unroll
            for (int jp = 0; jp < 4; ++jp) { S[ii][jp] = (f32x2){0.f, 0.f}; if (Sin) S[ii][jp] = *(const f32x2*)(Sin + ((size_t)hg * 64 + i0 + ii) * 64 + j0 + 2 * jp); }
    } else {
        c_mur = p.in[11][hc]; c_muk = p.in[11][1024 + hc]; c_muv = p.in[11][2048 + hc]; c_w0 = p.in[12][hc]; c_a0 = p.in[14][hc]; c_kk = p.in[17][hc]; c_ka = p.in[18][hc];
        c_rk = p.in[19][hc]; c_lg = p.in[20][hc]; c_lb = p.in[21][hc];
        if (samp) { c_pr = p.in[4][(size_t)b * CB + hc]; c_pk = p.in[4][(size_t)b * CB + 1024 + hc]; c_pv = p.in[4][(size_t)b * CB + 2048 + hc]; }
        else if (s > 0) { const bf16_t* sc = SC + ((size_t)((s & 1) * NB + b)) * CB; c_pr = bf2f(sc[hc]); c_pk = bf2f(sc[1024 + hc]); c_pv = bf2f(sc[2048 + hc]); }
    }
    auto load_tile = [&](int n) {
        LAS float* OP = (LAS float*)(L + (n & 1) * R_OP);
#pragma unroll 2
        for (int q = 0; q < 8; ++q) { const int tt = st0 + q, t = n * 16 + tt;
            if (t < T) {
                const size_t row = (size_t)(rbase + t); const bf16_t* Pr = P + row * NPAD + C_PB;
                const float pr = bf2f(Pr[hc]), pk = bf2f(Pr[1024 + hc]), pv = bf2f(Pr[2048 + hc]);
                float qr = c_pr, qk = c_pk, qv = c_pv;
                if (t > 0) { const bf16_t* Pq = Pr - NPAD; qr = bf2f(Pq[hc]); qk = bf2f(Pq[1024 + hc]); qv = bf2f(Pq[2048 + hc]); }
                const float xr = pr + c_mur * (qr - pr), xk = pk + c_muk * (qk - pk), xv = pv + c_muv * (qv - pv);
                const bf16_t* Lr = LR + row * 3072;
                const float lwv = bf2f(Lr[hc]), la = bf2f(Lr[1024 + hc]), lg = bf2f(Lr[2048 + hc]);
                const float wl = -softplusf(-(c_w0 + lwv)) - 0.5f; const float dec = __expf(-__expf(wl));
                const float asig = sigm(c_a0 + la);
                const float kkv = xk * c_kk; const float ss = wave_sum(kkv * kkv); const float kk = kkv * rsqrtf(ss + 1e-6f);
                const float kmod = xk * (1.f + (asig - 1.f) * c_ka);
                LAS float* o = OP + ((hh_l * 16 + tt) * 7) * 64 + lane;
                o[0] = dec; o[64] = -kk; o[128] = kk * asig; o[192] = kmod; o[256] = xr; o[320] = xv; o[384] = lg;
            } }
    };
    auto post_tile = [&](int n) {
        const LAS float* OP = (const LAS float*)(L + (n & 1) * R_OP); const LAS float* YB = (const LAS float*)(L + R_YB + (n & 1) * 8192);
#pragma unroll 2
        for (int q = 0; q < 8; ++q) { const int tt = st0 + q, t = n * 16 + tt;
            if (t < T) {
                const size_t row = (size_t)(rbase + t);
                const float y = YB[(hh_l * 16 + tt) * 64 + lane];
                const float mu = wave_sum(y) * (1.f / 64.f); const float d = y - mu; const float var = wave_sum(d * d) * (1.f / 64.f);
                const float yn = d * rsqrtf(var + 64e-5f) * c_lg + c_lb;
                const LAS float* o = OP + ((hh_l * 16 + tt) * 7) * 64 + lane;
                const float bs = wave_sum(o[256] * o[192] * c_rk);
                const float outv = (yn + bs * o[320]) * o[384];
                const float gb = sigm(bf2f(P[row * NPAD + C_GB + hc]));
                const float oa = bf2f(MG[row * 1024 + hc]);
                MG[row * 1024 + hc] = f2bf(oa + gb * outv);
            } }
    };
    if (!scanner) load_tile(0);
    __syncthreads();
    for (int n = 0; n < NT; ++n) {
        if (scanner) {
            const LAS float* OP = (const LAS float*)(L + (n & 1) * R_OP); LAS float* YB = (LAS float*)(L + R_YB + (n & 1) * 8192);
            const int nst = (T - n * 16) < 16 ? (T - n * 16) : 16;
            for (int tt = 0; tt < nst; ++tt) {
                const LAS float* op = OP + ((hh_s * 16 + tt) * 7) * 64;
                f32x2 wv[4], av[4], bv[4], kv[4], rv[4];
#pragma unroll
                for (int x = 0; x < 2; ++x) {
                    const f32x4 t0 = *(const LAS f32x4*)(op + j0 + 4 * x); wv[2 * x] = (f32x2){t0[0], t0[1]}; wv[2 * x + 1] = (f32x2){t0[2], t0[3]};
                    const f32x4 t1 = *(const LAS f32x4*)(op + 64 + j0 + 4 * x); av[2 * x] = (f32x2){t1[0], t1[1]}; av[2 * x + 1] = (f32x2){t1[2], t1[3]};
                    const f32x4 t2 = *(const LAS f32x4*)(op + 128 + j0 + 4 * x); bv[2 * x] = (f32x2){t2[0], t2[1]}; bv[2 * x + 1] = (f32x2){t2[2], t2[3]};
                    const f32x4 t3 = *(const LAS f32x4*)(op + 192 + j0 + 4 * x); kv[2 * x] = (f32x2){t3[0], t3[1]}; kv[2 * x + 1] = (f32x2){t3[2], t3[3]};
                    const f32x4 t4 = *(const LAS f32x4*)(op + 256 + j0 + 4 * x); rv[2 * x] = (f32x2){t4[0], t4[1]}; rv[2 * x + 1] = (f32x2){t4[2], t4[3]};
                }
                const f32x4 vv = *(const LAS f32x4*)(op + 320 + i0);
                float sa[4];
#pragma unroll
                for (int ii = 0; ii < 4; ++ii) { const f32x2 pa = S[ii][0] * av[0] + S[ii][1] * av[1], pb = S[ii][2] * av[2] + S[ii][3] * av[3]; const f32x2 pc = pa + pb; sa[ii] = reduce8(pc[0] + pc[1]); }
                f32x4 yv;
#pragma unroll
                for (int ii = 0; ii < 4; ++ii) { const f32x2 sav = (f32x2){sa[ii], sa[ii]}, vi = (f32x2){vv[ii], vv[ii]};
                    f32x2 ya = (f32x2){0.f, 0.f};
#pragma unroll
                    for (int jp = 0; jp < 4; ++jp) { S[ii][jp] = S[ii][jp] * wv[jp] + (sav * bv[jp] + vi * kv[jp]); ya += S[ii][jp] * rv[jp]; }
                    yv[ii] = reduce8(ya[0] + ya[1]); }
                if (jg == 0) *(LAS f32x4*)(YB + (hh_s * 16 + tt) * 64 + i0) = yv;
            }
        } else {
            if (n > 0) post_tile(n - 1);
            if (n + 1 < NT) load_tile(n + 1);
        }
        __syncthreads();
    }
    if (!scanner) post_tile(NT - 1);
    else {
#pragma unroll
        for (int ii = 0; ii < 4; ++ii)
#pragma unroll
            for (int jp = 0; jp < 4; ++jp) *(f32x2*)(Sout + ((size_t)hg * 64 + i0 + ii) * 64 + j0 + 2 * jp) = S[ii][jp];
    }
    __syncthreads();
}

__device__ __forceinline__ void ph_seq(const Params& p, lds_t L, int s) {
    for (int blk = blockIdx.x; blk < NB * 8; blk += gridDim.x) {
        const int b = blk >> 3, h = blk & 7;
        float* gst = p.out + O_GP + ((size_t)(b * 8 + h)) * 16384;
#ifndef NO_GDN
        gdn_seq(p, L, b * TS, TS / 64, 64, (b << 6) + h, h, s > 0 ? gst : nullptr, gst);
#endif
        float* wst = p.out + O_WP + (size_t)b * 16 * 4096;
#ifndef NO_RWKV
        rwkv_seq(p, L, s, b * TS, TS, false, b, h, s > 0 ? wst : nullptr, wst);
#endif
    }
#ifndef NO_SAMP
    if (s == 0) for (int blk = blockIdx.x; blk < NSB * 8; blk += gridDim.x) {
        const int sb = blk >> 3, h = blk & 7;
        gdn_seq(p, L, MPR + sb * NSS, 1, NSS, NITEM_P + blk, h, p.in[3] + ((size_t)(sb * 8 + h)) * 16384, p.out + O_GS + ((size_t)(sb * 8 + h)) * 16384);
        rwkv_seq(p, L, s, MPR + sb * NSS, NSS, true, sb, h, p.in[5] + (size_t)sb * 16 * 4096, p.out + O_WS + (size_t)sb * 16 * 4096);
    }
#endif
}

#ifdef ONLY
#define EN(x) ((x) == ONLY)
#elif defined(ENMASK)
#define EN(x) (((ENMASK) >> ((x) == 100 ? 11 : (x))) & 1)
#else
#define EN(x) true
#endif
__global__ __launch_bounds__(512, 2) void mega(Params p) {
    extern __shared__ __attribute__((aligned(16))) unsigned char shm[];
    lds_t L = (lds_t)shm;
    cg::grid_group grid = cg::this_grid();
    for (int ph = p.ph_lo; ph < p.ph_hi; ++ph) {
        if (ph == 0) { if (EN(100)) ph_wprep(p, L); }
        else {
            const int s = (ph - 1) / 11, k = (ph - 1) % 11;
            const int mps = (s == 0) ? MP : MPR;
            if (k == 0) { if (EN(0)) ph_cvt(p, s); }
            else if ((k == 1 || k == 3) && EN(1)) {
                pg8::Gemm g; EpiB16<0> E;
                if (k == 1) { g.A = (const bf16_t*)(p.ws + W_XB); g.Bt = (const bf16_t*)(p.ws + W_WIN); g.M = mps; g.N = NPAD; g.K = 1024; E.O = (bf16_t*)(p.ws + W_P); E.ldc = NPAD; }
                else { g.A = (const bf16_t*)(p.ws + W_LA); g.Bt = (const bf16_t*)(p.ws + W_WLORA); g.M = mps; g.N = 3072; g.K = 256; E.O = (bf16_t*)(p.ws + W_L); E.ldc = 3072; }
                pg8::StaticOrder S; S.init(g.M, g.N, (int)gridDim.x, (int)blockIdx.x);
                pg8::gemm_phase<EpiB16<0>, pg8::StaticOrder, false>(L, g, S, E, nullptr);
            }
            else if (k == 2) { if (EN(2)) ph_prep(p, s); }
            else if (k == 4) { if (EN(4)) ph_gdnpre(p, L, s); }
            else if (k == 5) { if (EN(5)) ph_seq(p, L, s); }
            else if ((k == 6 || k == 9) && EN(6)) {
                pg8::Gemm g; EpiAdd E; E.C = (float*)(p.ws + W_PL); E.xp = p.in[0]; E.xs = p.in[1]; E.s = s;
                if (k == 6) { g.A = (const bf16_t*)(p.ws + W_MG); g.Bt = (const bf16_t*)(p.ws + W_WOUT); g.M = mps; g.N = 1024; g.K = 1024; E.mode = 0; }
                else { g.A = (const bf16_t*)(p.ws + W_P); g.Bt = (const bf16_t*)(p.ws + W_WFF2); g.M = mps; g.N = 1024; g.K = 4096; E.mode = 1; }
                pg8::StaticOrder S; S.init(g.M, g.N, (int)gridDim.x, (int)blockIdx.x);
                pg8::gemm_phase<EpiAdd, pg8::StaticOrder, false>(L, g, S, E, nullptr);
            }
            else if (k == 7) { if (EN(7)) ph_ln<0>(p, s); }
            else if (k == 8 && EN(8)) {
                pg8::Gemm g; EpiB16<1> E; g.A = (const bf16_t*)(p.ws + W_XB); g.Bt = (const bf16_t*)(p.ws + W_WFF1); g.M = mps; g.N = 4096; g.K = 1024; E.O = (bf16_t*)(p.ws + W_P); E.ldc = 4096;
                pg8::StaticOrder S; S.init(g.M, g.N, (int)gridDim.x, (int)blockIdx.x);
                pg8::gemm_phase<EpiB16<1>, pg8::StaticOrder, false>(L, g, S, E, nullptr);
            }
            else if (k == 10) { if (EN(10)) ph_ln<1>(p, s); }
        }
        if (ph + 1 < p.ph_hi) grid.sync();
    }
}

constexpr int NPHASE = 1 + NSEG * 11;
extern "C" void kernel_launch(void* const* d_in, const int* in_sizes, int n_in, void* d_out, int out_size, void* d_ws, size_t ws_size, hipStream_t stream) {
    static int grid = 0;
    if (grid == 0) {
        int dev = 0, cus = 0, per_cu = 0;
        hipGetDevice(&dev);
        hipDeviceGetAttribute(&cus, hipDeviceAttributeMultiprocessorCount, dev);
        if (hipFuncSetAttribute((const void*)mega, hipFuncAttributeMaxDynamicSharedMemorySize, LDS_BYTES) != hipSuccess) { fprintf(stderr, "hipFuncSetAttribute failed\n"); }
        if (hipOccupancyMaxActiveBlocksPerMultiprocessor(&per_cu, (const void*)mega, 512, LDS_BYTES) != hipSuccess || per_cu < 1) { fprintf(stderr, "occupancy query: %d\n", per_cu); per_cu = 1; }
        (void)hipGetLastError();
        grid = cus * 1;
        if (ws_size < W_END) { fprintf(stderr, "workspace too small: %zu < %zu\n", ws_size, (size_t)W_END); grid = -1; }
    }
    if (grid < 0) return;
    Params p{};
    for (int i = 0; i < 29; ++i) p.in[i] = (const float*)d_in[i];
    p.out = (float*)d_out; p.ws = (unsigned char*)d_ws;
#if defined(MK_MULTI)
    for (int ph = 0; ph < NPHASE; ++ph) { p.ph_lo = ph; p.ph_hi = ph + 1; hipLaunchKernelGGL(mega, dim3(grid), dim3(512), LDS_BYTES, stream, p); }
#else
    p.ph_lo = 0; p.ph_hi = NPHASE;
    void* args[] = {&p};
    hipError_t e = hipLaunchCooperativeKernel((const void*)mega, dim3(grid), dim3(512), args, LDS_BYTES, stream);
    if (e != hipSuccess) fprintf(stderr, "cooperative launch failed: %s (grid %d)\n", hipGetErrorString(e), grid);
#endif
}
```

```cpp
#include <hip/hip_runtime.h>
#include <hip/hip_cooperative_groups.h>
#include <cstdio>
namespace cg = cooperative_groups;
namespace pg8 {
#define PG8_LAS __attribute__((address_space(3)))
typedef unsigned short bf16_t;
typedef short bf16x8 __attribute__((ext_vector_type(8)));
typedef float f32x4 __attribute__((ext_vector_type(4)));
typedef unsigned u32x4 __attribute__((ext_vector_type(4)));
constexpr int BM = 256, BK = 64, HALF = 128, HTB = HALF * BK * 2  , STAGE_BYTES = 8 * HTB, NXCD = 8, WGM = 8;

__host__ __device__ __forceinline__ int lds_byte(int r, int c) { const int st = (r >> 4) * 2 + (c >> 5), rr = r & 15, cc = c & 31, ob = rr * 64 + cc * 2; return st * 1024 + (ob ^ (((ob >> 9) & 1) << 5)); }
__host__ __device__ __forceinline__ void stage_rc(int b, int& R, int& C) { const int st = b / 1024, sb = b % 1024, swz = sb ^ (((sb >> 9) & 1) << 5); R = (st >> 1) * 16 + swz / 64; C = (st & 1) * 32 + (swz % 64) / 2; }
__host__ __device__ __forceinline__ int perm32(int rho) { const int n = rho >> 4, i = rho & 15; return 8 * (i >> 2) + 4 * n + (i & 3); }

struct Unit { int pm, pn; };
struct Gemm { const bf16_t* A; const bf16_t* Bt; int M, N, K; int lda, ldb; };

struct StaticOrder {
    int nM, nN, nwg, G, c;
    __host__ __device__ void init(int M, int N, int G_, int c_) { nM = M / BM; nN = N / BM; nwg = nM * nN; G = G_; c = c_; }
    __host__ __device__ bool next(int i, Unit& u) const {
        const long L = (long)i * G + c; if (L >= nwg) return false;
        int wgid = (int)L; { const int q = nwg / NXCD, r = nwg % NXCD, xcd = wgid % NXCD, off = wgid / NXCD; wgid = (xcd < r ? xcd * (q + 1) : r * (q + 1) + (xcd - r) * q) + off; }
        const int nig = WGM * nN, gid = wgid / nig, fm = gid * WGM, gsz = (nM - fm) < WGM ? (nM - fm) : WGM;
        u.pm = fm + ((wgid % nig) % gsz); u.pn = (wgid % nig) / gsz; return true;
    }
    __device__ __forceinline__ void a_ready(const Unit&) const {}
    __device__ __forceinline__ void done(const Unit&) const {}
};
typedef float f32x2c __attribute__((ext_vector_type(2)));
typedef __bf16 bf16v2c __attribute__((ext_vector_type(2)));
__device__ __forceinline__ unsigned cvt_pk_bf16(float lo, float hi) { f32x2c f = {lo, hi}; bf16v2c v = __builtin_convertvector(f, bf16v2c); return __builtin_bit_cast(unsigned, v); }
template <class Epi, class Sched, bool STAMP = false>
__device__ __forceinline__ void gemm_phase(PG8_LAS unsigned char* lds, const Gemm g, const Sched& S, const Epi& E, unsigned long long* stamps) {
    int tid_l = threadIdx.x; asm volatile("" : "+v"(tid_l)); const int tid = tid_l, wid = __builtin_amdgcn_readfirstlane(tid >> 6), lane = tid & 63, wr = wid >> 2, wc = wid & 3, fr = lane & 15, fq = lane >> 4;
    const int K = g.K, nt = K / BK;
    int ts_lo = 0, ts_hi = 0, nts = 0; const unsigned long long rt_entry = STAMP ? (unsigned long long)wall_clock64() : 0ull;
#define PG8_STAMP() do { if (STAMP && wid == 0 && nts < 64) { const unsigned long long _c = (unsigned long long)clock64(); \
        ts_lo = (lane == nts) ? (int)(unsigned)_c : ts_lo; ts_hi = (lane == nts) ? (int)(unsigned)(_c >> 32) : ts_hi; ++nts; } } while (0)
    PG8_STAMP();
    unsigned voffA[2], voffB[2];
#pragma unroll
    for (int i = 0; i < 2; ++i) { int R, C; stage_rc(tid * 16 + i * 8192, R, C); const int Rb = Epi::PERM ? ((R & ~31) + perm32(R & 31)) : R;
        voffA[i] = (unsigned)(R * g.lda + C) * 2u; voffB[i] = (unsigned)(Rb * g.ldb + C) * 2u; }
    const size_t kstep = (size_t)(BK * 2);
    const size_t hstepA = (size_t)HALF * g.lda * 2, hstepB = (size_t)HALF * g.ldb * 2;
    const size_t tstepA = 2 * hstepA, tstepB = 2 * hstepB;
    const unsigned ldsw = (unsigned)wid * 1024u;
    const int aoff = lds_byte(wr * 64 + fr, fq * 8), boff = lds_byte(wc * 32 + fr, fq * 8);
#define PG8_SA(b, h) (((b) * 2 + (h)) * HTB)
#define PG8_SB(b, h) ((4 + (b) * 2 + (h)) * HTB)
#define PG8_STAGE(bufoff, gbase, voff) do { _Pragma("unroll") for (int _i = 0; _i < 2; ++_i) \
        __builtin_amdgcn_global_load_lds((const unsigned*)((const char*)(gbase) + (voff)[_i]), (PG8_LAS unsigned*)(lds + (bufoff) + ldsw + _i * 8192), 16, 0, 0); } while (0)
#define PG8_LDA(dst, b, h) do { _Pragma("unroll") for (int m = 0; m < 4; ++m) _Pragma("unroll") for (int k = 0; k < 2; ++k) dst[m][k] = *(const PG8_LAS bf16x8*)(lds + PG8_SA(b, h) + aoff + m * 2048 + k * 1024); } while (0)
#define PG8_LDB(dst, b, h) do { _Pragma("unroll") for (int n = 0; n < 2; ++n) _Pragma("unroll") for (int k = 0; k < 2; ++k) dst[n][k] = *(const PG8_LAS bf16x8*)(lds + PG8_SB(b, h) + boff + n * 2048 + k * 1024); } while (0)
#define PG8_MMA(ai, bj, At, Bt) do { __builtin_amdgcn_s_setprio(1); _Pragma("unroll") for (int m = 0; m < 4; ++m) _Pragma("unroll") for (int n = 0; n < 2; ++n) _Pragma("unroll") for (int k = 0; k < 2; ++k) \
        acc[ai][bj][m][n] = __builtin_amdgcn_mfma_f32_16x16x32_bf16(Bt[n][k], At[m][k], acc[ai][bj][m][n], 0, 0, 0); __builtin_amdgcn_s_setprio(0); } while (0)
#define PG8_WAIT_V(n) asm volatile("s_waitcnt vmcnt(" #n ")" ::: "memory")
#define PG8_WAIT_L(n) asm volatile("s_waitcnt lgkmcnt(" #n ")" ::: "memory")
#define PG8_BAR __builtin_amdgcn_s_barrier()
#define PG8_SCHED __builtin_amdgcn_sched_barrier(0)
    Unit cur, nxt; int ui = 0;
    if (!S.next(0, cur)) return;
    f32x4 acc[2][2][4][2];
#pragma unroll
    for (int a = 0; a < 2; ++a)
#pragma unroll
        for (int b = 0; b < 2; ++b)
#pragma unroll
            for (int m = 0; m < 4; ++m)
#pragma unroll
                for (int n = 0; n < 2; ++n) acc[a][b][m][n] = (f32x4){0.f, 0.f, 0.f, 0.f};
    bf16x8 At[4][2], B0[2][2], B1[2][2];
    const char* cA = (const char*)g.A + (size_t)cur.pm * tstepA; const char* cB = (const char*)g.Bt + (size_t)cur.pn * tstepB;
    S.a_ready(cur);
    PG8_STAGE(PG8_SB(0, 0), cB, voffB); PG8_STAGE(PG8_SA(0, 0), cA, voffA); PG8_STAGE(PG8_SB(0, 1), cB + hstepB, voffB); PG8_STAGE(PG8_SA(0, 1), cA + hstepA, voffA);
    if (wr == 1) PG8_BAR;
    PG8_WAIT_V(4); PG8_BAR;
    PG8_STAGE(PG8_SB(1, 0), cB + kstep, voffB); PG8_STAGE(PG8_SA(1, 0), cA + kstep, voffA); PG8_STAGE(PG8_SB(1, 1), cB + hstepB + kstep, voffB);
    PG8_WAIT_V(6); PG8_BAR;
    PG8_STAMP();
    for (;;) {
        const bool has_next = S.next(ui + 1, nxt);
        const char* nA = has_next ? (const char*)g.A + (size_t)nxt.pm * tstepA : cA; const char* nB = has_next ? (const char*)g.Bt + (size_t)nxt.pn * tstepB : cB;
        for (int t = 0; t < nt; t += 2) {
            const bool last = (t == nt - 2);
            const char* a1 = cA + (size_t)(t + 1) * kstep;
            const char* a2 = last ? nA : cA + (size_t)(t + 2) * kstep; const char* b2 = last ? nB : cB + (size_t)(t + 2) * kstep;
            const char* a3 = a2 + kstep; const char* b3 = b2 + kstep;
            if (last && has_next) S.a_ready(nxt);
            PG8_LDB(B0, 0, 0); PG8_SCHED; PG8_LDA(At, 0, 0); PG8_STAGE(PG8_SA(1, 1), a1 + hstepA, voffA);
            PG8_WAIT_L(8); PG8_BAR; PG8_WAIT_L(0); PG8_MMA(0, 0, At, B0); PG8_BAR; PG8_SCHED;
            PG8_LDB(B1, 0, 1); PG8_STAGE(PG8_SB(0, 0), b2, voffB);
            PG8_BAR; PG8_WAIT_L(0); PG8_MMA(0, 1, At, B1); PG8_BAR;
            PG8_LDA(At, 0, 1); PG8_STAGE(PG8_SA(0, 0), a2, voffA);
            PG8_BAR; PG8_WAIT_L(0); PG8_MMA(1, 0, At, B0); PG8_BAR; PG8_SCHED;
            PG8_STAGE(PG8_SB(0, 1), b2 + hstepB, voffB);
            PG8_WAIT_V(6); PG8_BAR; PG8_MMA(1, 1, At, B1); PG8_BAR;
            PG8_LDB(B0, 1, 0); PG8_SCHED; PG8_LDA(At, 1, 0); PG8_STAGE(PG8_SA(0, 1), a2 + hstepA, voffA);
            PG8_WAIT_L(8); PG8_BAR; PG8_WAIT_L(0); PG8_MMA(0, 0, At, B0); PG8_BAR; PG8_SCHED;
            PG8_LDB(B1, 1, 1); PG8_STAGE(PG8_SB(1, 0), b3, voffB);
            PG8_BAR; PG8_WAIT_L(0); PG8_MMA(0, 1, At, B1); PG8_BAR;
            PG8_LDA(At, 1, 1); PG8_STAGE(PG8_SA(1, 0), a3, voffA);
            PG8_BAR; PG8_WAIT_L(0); PG8_MMA(1, 0, At, B0); PG8_BAR; PG8_SCHED;
            PG8_STAGE(PG8_SB(1, 1), b3 + hstepB, voffB);
            PG8_WAIT_V(6); PG8_BAR; PG8_MMA(1, 1, At, B1); PG8_BAR;
        }
        PG8_STAMP();
        if constexpr (!Epi::AFTER_DRAIN) { E(acc, cur, wr, wc, fr, fq); S.done(cur); }
        PG8_STAMP();
        if (!has_next) break;
#pragma unroll
        for (int a = 0; a < 2; ++a)
#pragma unroll
            for (int b = 0; b < 2; ++b)
#pragma unroll
                for (int m = 0; m < 4; ++m)
#pragma unroll
                    for (int n = 0; n < 2; ++n) acc[a][b][m][n] = (f32x4){0.f, 0.f, 0.f, 0.f};
        cur = nxt; cA = nA; cB = nB; ++ui;
    }
    PG8_WAIT_V(0);
    if (wr == 0) PG8_BAR;
    PG8_BAR;
    if constexpr (Epi::AFTER_DRAIN) { E.fused(acc, cur, wr, wc, fr, fq, lds, wid, lane); S.done(cur); }
    PG8_STAMP();
    if (STAMP && wid == 0) { stamps[lane] = lane < nts ? (((unsigned long long)(unsigned)ts_hi << 32) | (unsigned)ts_lo) : 0ull;
        if (lane == 62) stamps[62] = rt_entry; if (lane == 63) stamps[63] = (unsigned long long)wall_clock64(); }
#undef PG8_STAMP
#undef PG8_SA
#undef PG8_SB
#undef PG8_STAGE
#undef PG8_LDA
#undef PG8_LDB
#undef PG8_MMA
#undef PG8_WAIT_V
#undef PG8_WAIT_L
#undef PG8_BAR
#undef PG8_SCHED
}
}
using pg8::bf16_t; using pg8::bf16x8; using pg8::f32x4; using pg8::u32x4; using pg8::cvt_pk_bf16;
typedef float f32x2 __attribute__((ext_vector_type(2)));
typedef unsigned u32x2 __attribute__((ext_vector_type(2)));
#define LAS __attribute__((address_space(3)))
typedef LAS unsigned char* lds_t;

constexpr int D = 1024, NB = 32, SEQ = 2048, NSB = 8, NSS = 16;
constexpr int TS = 512, NSEG = SEQ / TS;
constexpr int MPR = NB * TS;
constexpr int MP = MPR + 256;
constexpr int NSAMP = NSB * NSS;
constexpr int NPAD = 9728, COLS = 9488;
constexpr int C_Z = 3072, C_BETA = 4096, C_AR = 4104, C_PB = 4112, C_GA = 7440, C_GB = 8464, CB = 3328;
constexpr float DN_ALPHA = 1.189207115002721f;
constexpr int LDS_BYTES = 163840;
constexpr int LDF = 4096 + 64;
constexpr int NITEM_P = NB * (TS / 64) * 8;
constexpr int NITEM = NITEM_P + 64;

constexpr size_t O_YP = 0, O_YS = O_YP + (size_t)NB * SEQ * D, O_CP = O_YS + (size_t)NSAMP * D, O_GP = O_CP + (size_t)NB * 3 * 3072,
    O_SP = O_GP + (size_t)NB * 8 * 16384, O_WP = O_SP + (size_t)NB * CB, O_CS = O_WP + (size_t)NB * 16 * 4096, O_GS = O_CS + (size_t)NSB * 3 * 3072,
    O_SS = O_GS + (size_t)NSB * 8 * 16384, O_WS = O_SS + (size_t)NSB * CB;
constexpr size_t al256(size_t x) { return (x + 255) & ~(size_t)255; }
constexpr size_t W_WIN = 0, W_WLORA = W_WIN + al256((size_t)NPAD * 1024 * 2), W_WOUT = W_WLORA + al256((size_t)3072 * 256 * 2), W_WFF1 = W_WOUT + al256((size_t)1024 * 1024 * 2),
    W_WFF2 = W_WFF1 + al256((size_t)4096 * 1024 * 2), W_XB = W_WFF2 + al256((size_t)LDF * 1024 * 2), W_P = W_XB + al256((size_t)(NSEG * MPR + 256) * 1024 * 2), W_QKV = W_P + al256((size_t)MP * NPAD * 2),
    W_BG = W_QKV + al256((size_t)MP * 3072 * 2), W_LA = W_BG + al256((size_t)MP * 16 * 4), W_L = W_LA + al256((size_t)MP * 256 * 2), W_T = W_L + al256((size_t)MP * 3072 * 2),
    W_GC = W_T + al256((size_t)NITEM * 8192 * 2), W_MG = W_GC + al256((size_t)NITEM * 64 * 4), W_PL = W_MG + al256((size_t)MP * 1024 * 2), W_CC = W_PL + al256((size_t)MP * 1024 * 4),
    W_SC = W_CC + al256((size_t)2 * NB * 3 * 3072 * 2), W_HB = W_SC + al256((size_t)2 * NB * CB * 2), W_BAR = W_HB + al256((size_t)MP * 1024 * 2), W_END = W_BAR + 16384;

struct Params { const float* in[29]; float* out; unsigned char* ws; int ph_lo, ph_hi; int rep_mask, pad0; };

__device__ __forceinline__ int ltid() { int t = threadIdx.x; asm volatile("" : "+v"(t)); return t; }
__device__ __forceinline__ float bf2f(unsigned v) { return __uint_as_float(v << 16); }
__device__ __forceinline__ float bflo(unsigned v) { return __uint_as_float(v << 16); }
__device__ __forceinline__ float bfhi(unsigned v) { return __uint_as_float(v & 0xffff0000u); }
__device__ __forceinline__ bf16_t f2bf(float f) { return (bf16_t)(cvt_pk_bf16(f, 0.f) & 0xffffu); }
__device__ __forceinline__ float sigm(float x) { return __builtin_amdgcn_rcpf(1.0f + __expf(-x)); }
__device__ __forceinline__ float tanh_fast(float x) { return 1.0f - 2.0f * __builtin_amdgcn_rcpf(1.0f + __expf(2.0f * x)); }
__device__ __forceinline__ float softplus_fast(float x) { return x > 20.f ? x : __logf(1.0f + __expf(x)); }
__device__ __forceinline__ float siluf(float x) { return x * sigm(x); }
__device__ __forceinline__ float softplusf(float x) { return x > 20.f ? x : log1pf(__expf(x)); }
template <int CTRL> __device__ __forceinline__ float dppmov(float v) { return __int_as_float(__builtin_amdgcn_update_dpp(0, __float_as_int(v), CTRL, 0xf, 0xf, true)); }
__device__ __forceinline__ float wave_sum(float v) {
    v += dppmov<0xB1>(v); v += dppmov<0x4E>(v); v += dppmov<0x141>(v); v += dppmov<0x140>(v);
    const int vi = __float_as_int(v);
    const float r0 = __int_as_float(__builtin_amdgcn_readlane(vi, 0)), r1 = __int_as_float(__builtin_amdgcn_readlane(vi, 16)), r2 = __int_as_float(__builtin_amdgcn_readlane(vi, 32)), r3 = __int_as_float(__builtin_amdgcn_readlane(vi, 48));
    return (r0 + r1) + (r2 + r3);
}
template <int N> struct IC { static constexpr int value = N; };
template <int N> __device__ __forceinline__ void wave_sumN(float (&v)[N]) {
#pragma unroll
    for (int q = 0; q < N; ++q) v[q] += dppmov<0xB1>(v[q]);
#pragma unroll
    for (int q = 0; q < N; ++q) v[q] += dppmov<0x4E>(v[q]);
#pragma unroll
    for (int q = 0; q < N; ++q) v[q] += dppmov<0x141>(v[q]);
#pragma unroll
    for (int q = 0; q < N; ++q) v[q] += dppmov<0x140>(v[q]);
    float r0[N], r1[N], r2[N], r3[N];
#pragma unroll
    for (int q = 0; q < N; ++q) { const int vi = __float_as_int(v[q]);
        r0[q] = __int_as_float(__builtin_amdgcn_readlane(vi, 0)); r1[q] = __int_as_float(__builtin_amdgcn_readlane(vi, 16)); r2[q] = __int_as_float(__builtin_amdgcn_readlane(vi, 32)); r3[q] = __int_as_float(__builtin_amdgcn_readlane(vi, 48)); }
#pragma unroll
    for (int q = 0; q < N; ++q) v[q] = (r0[q] + r1[q]) + (r2[q] + r3[q]);
}
__device__ __forceinline__ float reduce8(float v) { v += dppmov<0xB1>(v); v += dppmov<0x4E>(v); v += dppmov<0x141>(v); return v; }
__device__ __forceinline__ void lds_barrier() { asm volatile("s_waitcnt lgkmcnt(0)" ::: "memory"); __builtin_amdgcn_s_barrier(); asm volatile("" ::: "memory"); }
__device__ __forceinline__ f32x4 mfma16(bf16x8 a, bf16x8 b, f32x4 c) { return __builtin_amdgcn_mfma_f32_16x16x32_bf16(a, b, c, 0, 0, 0); }

__device__ __forceinline__ const float* xrow_ptr(const Params& p, int r, int s) {
    if (r < MPR) { const int b = r / TS, tt = r % TS; return p.in[0] + ((size_t)(b * SEQ + s * TS + tt)) * D; }
    if (s == 0 && r < MPR + NSAMP) return p.in[1] + (size_t)(r - MPR) * D;
    return nullptr;
}
__device__ __forceinline__ float* yrow_ptr(const Params& p, int r, int s) {
    if (r < MPR) { const int b = r / TS, tt = r % TS; return p.out + O_YP + ((size_t)(b * SEQ + s * TS + tt)) * D; }
    return p.out + O_YS + (size_t)(r - MPR) * D;
}

template <int ACT> struct EpiB16 {
    static constexpr bool PERM = true, AFTER_DRAIN = false;
    bf16_t* O; int ldc; int hm;
    __device__ __forceinline__ void operator()(const f32x4 (&acc)[2][2][4][2], const pg8::Unit& u, int wr, int wc, int fr, int fq) const {
        const int row0 = u.pm * 256 + wr * 64 + fr, col0 = u.pn * 256 + wc * 32 + 8 * fq;
        if (ACT == 0 && hm) {
#pragma unroll
            for (int ai = 0; ai < 2; ++ai)
#pragma unroll
                for (int m = 0; m < 4; ++m) { const int row = row0 + ai * 128 + m * 16;
                    size_t rbase_; int tlen, rr;
                    if (row < MPR) { rbase_ = 0; tlen = TS; rr = row; } else { rbase_ = (size_t)MPR * 3072; tlen = NSS; rr = row - MPR; }
                    const int bb = rr / tlen, t = rr % tlen;
#pragma unroll
                    for (int bj = 0; bj < 2; ++bj) { const int c8 = col0 + bj * 128, vec = c8 >> 10, head = (c8 & 1023) >> 6, ch = c8 & 63;
                        const size_t off = rbase_ + ((((size_t)(bb * 8 + (head >> 1)) * tlen + t) * 2 + (head & 1)) * 3 + vec) * 64 + ch;
                        const f32x4 v0 = acc[ai][bj][m][0], v1 = acc[ai][bj][m][1];
                        u32x4 w; w.x = cvt_pk_bf16(v0[0], v0[1]); w.y = cvt_pk_bf16(v0[2], v0[3]); w.z = cvt_pk_bf16(v1[0], v1[1]); w.w = cvt_pk_bf16(v1[2], v1[3]);
                        if (row < MPR + NSAMP) *(u32x4*)(O + off) = w; } }
            return;
        }
#pragma unroll
        for (int ai = 0; ai < 2; ++ai)
#pragma unroll
            for (int m = 0; m < 4; ++m) { bf16_t* rowp = O + (size_t)(row0 + ai * 128 + m * 16) * ldc + col0;
#pragma unroll
                for (int bj = 0; bj < 2; ++bj) { f32x4 v0 = acc[ai][bj][m][0], v1 = acc[ai][bj][m][1];
                    if (ACT == 1) {
#pragma unroll
                        for (int j = 0; j < 4; ++j) { const float a = fmaxf(v0[j], 0.f), b = fmaxf(v1[j], 0.f); v0[j] = a * a; v1[j] = b * b; } }
                    u32x4 w; w.x = cvt_pk_bf16(v0[0], v0[1]); w.y = cvt_pk_bf16(v0[2], v0[3]); w.z = cvt_pk_bf16(v1[0], v1[1]); w.w = cvt_pk_bf16(v1[2], v1[3]);
                    *(u32x4*)(rowp + bj * 128) = w; } }
    }
};
struct EpiAdd {
    static constexpr bool PERM = false, AFTER_DRAIN = false;
    float* C; const float* xp; const float* xs; int s; int mode;
    __device__ __forceinline__ void operator()(const f32x4 (&acc)[2][2][4][2], const pg8::Unit& u, int wr, int wc, int fr, int fq) const {
        const int row0 = u.pm * 256 + wr * 64 + fr, col0 = u.pn * 256 + wc * 32 + 4 * fq;
#pragma unroll
        for (int ai = 0; ai < 2; ++ai)
#pragma unroll
            for (int m = 0; m < 4; ++m) { const int row = row0 + ai * 128 + m * 16; float* rowp = C + (size_t)row * 1024 + col0;
                const float* bp;
                if (mode) bp = rowp;
                else { if (row < MPR) { const int b = row / TS, tt = row % TS; bp = xp + ((size_t)(b * SEQ + s * TS + tt)) * D + col0; }
                       else if (s == 0 && row < MPR + NSAMP) bp = xs + (size_t)(row - MPR) * D + col0; else bp = nullptr; }
#pragma unroll
                for (int bj = 0; bj < 2; ++bj)
#pragma unroll
                    for (int n = 0; n < 2; ++n) { f32x4 bs = (f32x4){0.f, 0.f, 0.f, 0.f}; if (bp) bs = *(const f32x4*)(bp + bj * 128 + n * 16);
                        *(f32x4*)(rowp + bj * 128 + n * 16) = acc[ai][bj][m][n] + DN_ALPHA * bs; }
                asm volatile("" ::: "memory"); }
    }
};
__device__ __forceinline__ size_t xb_row0(int s);
__device__ __forceinline__ void ph_wprep(const Params& p, lds_t L) {
    LAS float* tile = (LAS float*)L;
    const int tid = ltid();
    bf16_t* xb = (bf16_t*)(p.ws + W_XB);
    const int cc = (tid & 127) * 8, G = gridDim.x, nr4 = (NSEG * MPR + 256) / 4;
    for (int i = 0; ; ++i) {
        const int it = blockIdx.x + i * G, cbase = blockIdx.x + i * 4 * G;
        const bool hasW = it < 4736, hasC = cbase < nr4;
        if (!hasW && !hasC) break;
        f32x4 ca[4], cb[4];
        if (hasC) {
#pragma unroll
            for (int u = 0; u < 4; ++u) { const int r4 = cbase + u * G; ca[u] = (f32x4){0.f, 0.f, 0.f, 0.f}; cb[u] = ca[u];
                if (r4 < nr4) { const int ra = r4 * 4 + (tid >> 7); const float* src;
                    if (ra < MP) src = xrow_ptr(p, ra, 0); else { const int q = ra - MP; src = xrow_ptr(p, q % MPR, 1 + q / MPR); }
                    if (src) { ca[u] = *(const f32x4*)(src + cc); cb[u] = *(const f32x4*)(src + cc + 4); } } }
        }
        if (hasW) {
            const float* W; bf16_t* WT; int K, N, NP_; int r = it; int ldw = 0;
            if (r < 2432) { W = p.in[6]; WT = (bf16_t*)(p.ws + W_WIN); K = 1024; N = COLS; NP_ = NPAD; }
            else if ((r -= 2432) < 256) { W = p.in[22]; WT = (bf16_t*)(p.ws + W_WOUT); K = 1024; N = 1024; NP_ = 1024; }
            else if ((r -= 256) < 1024) { W = p.in[25]; WT = (bf16_t*)(p.ws + W_WFF1); K = 1024; N = 4096; NP_ = 4096; }
            else { r -= 1024; W = p.in[26]; WT = (bf16_t*)(p.ws + W_WFF2); K = 4096; N = 1024; NP_ = 1024; ldw = LDF; }
            if (ldw == 0) ldw = K;
            const int ntl = NP_ / 64, k0 = (r / ntl) * 64, n0 = (r % ntl) * 64;
            { const int j = tid & 63, i0 = tid >> 6;
#pragma unroll
              for (int q = 0; q < 8; ++q) { const int ii = i0 + 8 * q; tile[ii * 65 + j] = (n0 + j < N) ? W[(size_t)(k0 + ii) * N + n0 + j] : 0.f; } }
            __syncthreads();
            { const int k2 = (tid & 31) * 2, nn = tid >> 5;
#pragma unroll
              for (int q = 0; q < 4; ++q) { const int n = nn + 16 * q; *(unsigned*)(WT + (size_t)(n0 + n) * ldw + k0 + k2) = cvt_pk_bf16(tile[k2 * 65 + n], tile[(k2 + 1) * 65 + n]); } }
            __syncthreads();
        }
        if (hasC) {
#pragma unroll
            for (int u = 0; u < 4; ++u) { const int r4 = cbase + u * G;
                if (r4 < nr4) { u32x4 o; o.x = cvt_pk_bf16(ca[u][0], ca[u][1]); o.y = cvt_pk_bf16(ca[u][2], ca[u][3]); o.z = cvt_pk_bf16(cb[u][0], cb[u][1]); o.w = cvt_pk_bf16(cb[u][2], cb[u][3]);
                    *(u32x4*)(xb + (size_t)(r4 * 4 + (tid >> 7)) * 1024 + cc) = o; } }
        }
    }
    bf16_t* WL = (bf16_t*)(p.ws + W_WLORA);
    for (int idx = blockIdx.x * 512 + tid; idx < 3072 * 256; idx += gridDim.x * 512) {
        const int n = idx >> 8, k = idx & 255; float v = 0.f;
        if (n < 1024) { if (k < 64) v = p.in[13][k * 1024 + n]; }
        else if (n < 2048) { if (k >= 64 && k < 128) v = p.in[15][(k - 64) * 1024 + n - 1024]; }
        else { if (k >= 128) v = p.in[16][(k - 128) * 1024 + n - 2048]; }
        WL[idx] = f2bf(v);
    }
}
__device__ __forceinline__ size_t xb_row0(int s) { return (size_t)s * MPR + (s > 0 ? 256 : 0); }
__device__ __forceinline__ void ph_cvt_all(const Params& p) {
    bf16_t* xb = (bf16_t*)(p.ws + W_XB);
    const int tid = ltid();
    const int c = (tid & 127) * 8, G = gridDim.x, nr4 = (NSEG * MPR + 256) / 4;
    for (int base = blockIdx.x; base < nr4; base += 4 * G) {
        f32x4 a[4], b[4];
#pragma unroll
        for (int u = 0; u < 4; ++u) { const int r4 = base + u * G; a[u] = (f32x4){0.f, 0.f, 0.f, 0.f}; b[u] = a[u];
            if (r4 < nr4) { const int ra = r4 * 4 + (tid >> 7); const float* src;
                if (ra < MP) src = xrow_ptr(p, ra, 0); else { const int q = ra - MP; src = xrow_ptr(p, q % MPR, 1 + q / MPR); }
                if (src) { a[u] = *(const f32x4*)(src + c); b[u] = *(const f32x4*)(src + c + 4); } } }
#pragma unroll
        for (int u = 0; u < 4; ++u) { const int r4 = base + u * G;
            if (r4 < nr4) { u32x4 o; o.x = cvt_pk_bf16(a[u][0], a[u][1]); o.y = cvt_pk_bf16(a[u][2], a[u][3]); o.z = cvt_pk_bf16(b[u][0], b[u][1]); o.w = cvt_pk_bf16(b[u][2], b[u][3]);
                *(u32x4*)(xb + (size_t)(r4 * 4 + (tid >> 7)) * 1024 + c) = o; } }
    }
}
__device__ __forceinline__ void ph_prep(const Params& p, int s) {
    const bf16_t* P = (const bf16_t*)(p.ws + W_P);
    bf16_t* QKV = (bf16_t*)(p.ws + W_QKV); float* BG = (float*)(p.ws + W_BG); bf16_t* LA = (bf16_t*)(p.ws + W_LA);
    bf16_t* CC = (bf16_t*)(p.ws + W_CC); bf16_t* SC = (bf16_t*)(p.ws + W_SC);
    const int tid = ltid();
    constexpr int GR = 16;
    const int ngr = ((s == 0) ? (MPR + NSAMP) : MPR) / GR;
    const float* cw = p.in[7];
    for (int g = blockIdx.x; g < ngr; g += gridDim.x) {
        const int r0 = g * GR; const bool samp = r0 >= MPR;
        const int b = samp ? (r0 - MPR) / NSS : r0 / TS, tt0 = samp ? (r0 - MPR) % NSS : r0 % TS, tlen = samp ? NSS : TS;
        const bool lastg = (tt0 == tlen - GR);
        unsigned raw[3][GR + 3]; float xf0[3][3], xf1[3][3];
        const int cmode = (tt0 > 0) ? 0 : (samp ? 1 : (s > 0 ? 2 : 3));
#pragma unroll
        for (int sec = 0; sec < 3; ++sec) { const int ch = sec * 1024 + 2 * tid;
#pragma unroll
            for (int q = 0; q < GR + 3; ++q) {
                if (q >= 3 || cmode == 0) raw[sec][q] = *(const unsigned*)(P + (size_t)(r0 - 3 + q) * NPAD + ch);
                else if (cmode == 2) raw[sec][q] = *(const unsigned*)(CC + ((size_t)((s & 1) * NB + b) * 3 + q) * 3072 + ch);
                else raw[sec][q] = 0u;
                if (q < 3) { xf0[sec][q] = 0.f; xf1[sec][q] = 0.f; if (cmode == 1) { const float* sp = p.in[2] + ((size_t)(b * 3 + q)) * 3072 + ch; xf0[sec][q] = sp[0]; xf1[sec][q] = sp[1]; } }
            } }
        float lpv[GR / 2], lprev[GR / 2];
#pragma unroll
        for (int e = 0; e < GR / 2; ++e) { const int item = tid + 512 * e, j = item >> 8, c = item & 255, col = 3072 + c;
            lpv[e] = bf2f(P[(size_t)(r0 + j) * NPAD + C_PB + col]);
            if (tt0 + j > 0) lprev[e] = bf2f(P[(size_t)(r0 + j - 1) * NPAD + C_PB + col]);
            else if (samp) lprev[e] = p.in[4][(size_t)b * CB + col];
            else if (s > 0) lprev[e] = bf2f(SC[((size_t)((s & 1) * NB + b)) * CB + col]);
            else lprev[e] = 0.f; }
#pragma unroll
        for (int sec = 0; sec < 3; ++sec) {
            const int ch = sec * 1024 + 2 * tid;
            float x0[GR + 3], x1[GR + 3];
#pragma unroll
            for (int q = 0; q < GR + 3; ++q) { x0[q] = bflo(raw[sec][q]); x1[q] = bfhi(raw[sec][q]); if (q < 3 && cmode == 1) { x0[q] = xf0[sec][q]; x1[q] = xf1[sec][q]; } }
            float w0[4], w1[4];
#pragma unroll
            for (int j = 0; j < 4; ++j) { w0[j] = cw[j * 3072 + ch]; w1[j] = cw[j * 3072 + ch + 1]; }
#pragma unroll
            for (int j = 0; j < GR; ++j) {
                float y0 = 0.f, y1 = 0.f;
#pragma unroll
                for (int t = 0; t < 4; ++t) { y0 += w0[t] * x0[j + t]; y1 += w1[t] * x1[j + t]; }
                y0 = siluf(y0); y1 = siluf(y1);
                if (sec < 2) { const float ss = wave_sum(y0 * y0 + y1 * y1); float rn = rsqrtf(ss + 1e-6f); if (sec == 0) rn *= 0.08838834764831845f; y0 *= rn; y1 *= rn; }
                *(unsigned*)(QKV + (size_t)(r0 + j) * 3072 + ch) = cvt_pk_bf16(y0, y1);
            }
            if (lastg) {
#pragma unroll
                for (int j = GR - 3; j < GR; ++j) { const int ci = j - (GR - 3);
                    if (!samp) { *(unsigned*)(CC + ((size_t)(((s + 1) & 1) * NB + b) * 3 + ci) * 3072 + ch) = raw[sec][j + 3];
                        if (s == NSEG - 1) { float* o = p.out + O_CP + ((size_t)(b * 3 + ci)) * 3072 + ch; o[0] = x0[j + 3]; o[1] = x1[j + 3]; } }
                    else { float* o = p.out + O_CS + ((size_t)(b * 3 + ci)) * 3072 + ch; o[0] = x0[j + 3]; o[1] = x1[j + 3]; }
                }
            }
        }
        if (tid < GR * 8) { const int j = tid >> 3, h = tid & 7; const bf16_t* Pr = P + (size_t)(r0 + j) * NPAD;
            const float br = bf2f(Pr[C_BETA + h]), ar = bf2f(Pr[C_AR + h]);
            BG[(size_t)(r0 + j) * 16 + h] = sigm(br); BG[(size_t)(r0 + j) * 16 + 8 + h] = -__expf(p.in[8][h]) * softplusf(ar + p.in[9][h]); }
#pragma unroll
        for (int e = 0; e < GR / 2; ++e) { const int item = tid + 512 * e, j = item >> 8, c = item & 255, col = 3072 + c;
            const float pv = lpv[e], prev = lprev[e];
            const float xs = pv + p.in[11][col] * (prev - pv);
            const float v = (c < 64) ? tanh_fast(xs) : ((c < 128) ? xs : sigm(xs));
            LA[(size_t)(r0 + j) * 256 + c] = f2bf(v); }
        if (lastg) { const bf16_t* Pr = P + (size_t)(r0 + GR - 1) * NPAD + C_PB;
            for (int c = tid; c < CB; c += 512) { const bf16_t v = Pr[c];
                if (!samp) { SC[((size_t)(((s + 1) & 1) * NB + b)) * CB + c] = v; if (s == NSEG - 1) p.out[O_SP + (size_t)b * CB + c] = bf2f(v); }
                else p.out[O_SS + (size_t)b * CB + c] = bf2f(v); } }
    }
}
template <int WHICH> __device__ __forceinline__ void ph_ln(const Params& p, int s) {
    float* PL = (float*)(p.ws + W_PL); bf16_t* hb = (bf16_t*)(p.ws + W_HB);
    const int tidl = ltid(); const int lane = tidl & 63, wave = tidl >> 6, nv = (s == 0) ? (MPR + NSAMP) : MPR;
    const float* gg = p.in[WHICH == 0 ? 23 : 27]; const float* bb = p.in[WHICH == 0 ? 24 : 28];
    f32x4 gv[4], bv[4];
#pragma unroll
    for (int j = 0; j < 4; ++j) { gv[j] = *(const f32x4*)(gg + (lane + 64 * j) * 4); bv[j] = *(const f32x4*)(bb + (lane + 64 * j) * 4); }
    const int stride = gridDim.x * 8;
    int r = blockIdx.x * 8 + wave;
    f32x4 v[4];
    if (r < nv) {
#pragma unroll
        for (int j = 0; j < 4; ++j) v[j] = *(const f32x4*)(PL + (size_t)r * 1024 + (lane + 64 * j) * 4); }
    for (; r < nv; r += stride) {
        float* xr = PL + (size_t)r * 1024;
        f32x4 vn[4];
#pragma unroll
        for (int j = 0; j < 4; ++j) vn[j] = v[j];
        if (r + stride < nv) {
#pragma unroll
            for (int j = 0; j < 4; ++j) vn[j] = *(const f32x4*)(PL + (size_t)(r + stride) * 1024 + (lane + 64 * j) * 4); }
        float sm = 0.f;
#pragma unroll
        for (int j = 0; j < 4; ++j) sm += (v[j][0] + v[j][1]) + (v[j][2] + v[j][3]);
        const float mean = wave_sum(sm) * (1.f / 1024.f); float s2 = 0.f;
#pragma unroll
        for (int j = 0; j < 4; ++j) { v[j] = v[j] - mean; s2 += (v[j][0] * v[j][0] + v[j][1] * v[j][1]) + (v[j][2] * v[j][2] + v[j][3] * v[j][3]); }
        const float rstd = rsqrtf(wave_sum(s2) * (1.f / 1024.f) + 1e-5f);
        float* yo = (WHICH == 0) ? xr : yrow_ptr(p, r, s);
#pragma unroll
        for (int j = 0; j < 4; ++j) { const f32x4 o = v[j] * rstd * gv[j] + bv[j]; *(f32x4*)(yo + (lane + 64 * j) * 4) = o;
            if (WHICH == 0) { u32x2 w; w.x = cvt_pk_bf16(o[0], o[1]); w.y = cvt_pk_bf16(o[2], o[3]); *(u32x2*)(hb + (size_t)r * 1024 + (lane + 64 * j) * 4) = w; } }
#pragma unroll
        for (int j = 0; j < 4; ++j) v[j] = vn[j];
    }
}
__device__ __forceinline__ void ph_gdnpre(const Params& p, lds_t L, int s) {
    const bf16_t* QKV = (const bf16_t*)(p.ws + W_QKV); const float* BG = (const float*)(p.ws + W_BG);
    bf16_t* Tm = (bf16_t*)(p.ws + W_T); float* GC = (float*)(p.ws + W_GC);
    const int tidl = ltid(); const int lane = tidl & 63, wave = tidl >> 6, l15 = lane & 15, lq = lane >> 4;
    LAS float* Af = (LAS float*)(L + wave * 16896); LAS float* gcs = Af + 4096; LAS float* bts = gcs + 64;
    const int ni = (s == 0) ? NITEM : NITEM_P;
    for (int it = blockIdx.x * 8 + wave; it < ni; it += gridDim.x * 8) {
        int row0, h, nvalid;
        if (it < NITEM_P) { const int b = it >> 6, ck = (it >> 3) & 7; h = it & 7; row0 = b * TS + ck * 64; nvalid = 64; }
        else { const int j = it - NITEM_P; h = j & 7; row0 = MPR + (j >> 3) * NSS; nvalid = NSS; }
        float g = 0.f, bt = 0.f;
        if (lane < nvalid) { g = BG[(size_t)(row0 + lane) * 16 + 8 + h]; bt = BG[(size_t)(row0 + lane) * 16 + h]; }
#pragma unroll
        for (int o = 1; o < 64; o <<= 1) { const float t = __shfl_up(g, o); if (lane >= o) g += t; }
        gcs[lane] = g; bts[lane] = bt;
        f32x4 acc[4][4];
#pragma unroll
        for (int I = 0; I < 4; ++I)
#pragma unroll
            for (int J = 0; J < 4; ++J) acc[I][J] = (f32x4){0.f, 0.f, 0.f, 0.f};
#pragma unroll
        for (int kk = 0; kk < 4; ++kk) {
            bf16x8 fr[4];
#pragma unroll
            for (int I = 0; I < 4; ++I) { const int row = 16 * I + l15; u32x4 v = (u32x4){0u, 0u, 0u, 0u};
                if (row < nvalid) v = *(const u32x4*)(QKV + (size_t)(row0 + row) * 3072 + 1024 + h * 128 + kk * 32 + 8 * lq);
                fr[I] = __builtin_bit_cast(bf16x8, v); }
#pragma unroll
            for (int I = 0; I < 4; ++I)
#pragma unroll
                for (int J = 0; J <= I; ++J) acc[I][J] = mfma16(fr[I], fr[J], acc[I][J]);
            asm volatile("" ::: "memory");
        }
        asm volatile("s_waitcnt lgkmcnt(0)" ::: "memory");
#pragma unroll
        for (int I = 0; I < 4; ++I)
#pragma unroll
            for (int J = 0; J < 4; ++J)
#pragma unroll
                for (int jj = 0; jj < 4; ++jj) { const int i = 16 * I + 4 * lq + jj, j = 16 * J + l15;
                    float val = 0.f; if (J <= I && i > j) val = bts[i] * acc[I][J][jj] * __expf(gcs[i] - gcs[j]);
                    Af[i * 64 + j] = val; }
        asm volatile("s_waitcnt lgkmcnt(0)" ::: "memory");
        float t[64];
        int ll = lane; asm volatile("" : "+v"(ll));
#pragma unroll
        for (int i = 0; i < 64; ++i) {
            float a0 = (ll == i) ? 1.f : 0.f, a1 = 0.f;
#pragma unroll
            for (int j4 = 0; j4 < i; j4 += 4) { const f32x4 av = *(const LAS f32x4*)(Af + i * 64 + j4);
                a0 -= av[0] * t[j4]; if (j4 + 1 < i) a1 -= av[1] * t[j4 + 1]; if (j4 + 2 < i) a0 -= av[2] * t[j4 + 2]; if (j4 + 3 < i) a1 -= av[3] * t[j4 + 3]; }
            t[i] = a0 + a1;
            asm volatile("" ::: "memory");
        }
        const float sb = bts[lane], sg = sb * __expf(gcs[lane]);
        const float gcl = gcs[lane];
        asm volatile("s_waitcnt lgkmcnt(0)" ::: "memory");
        LAS bf16_t* TL = (LAS bf16_t*)Af;
#pragma unroll
        for (int i = 0; i < 64; ++i) { TL[i * 64 + lane] = f2bf(t[i] * sb); TL[4096 + i * 64 + lane] = f2bf(t[i] * sg); if ((i & 3) == 3) asm volatile("" ::: "memory"); }
        asm volatile("s_waitcnt lgkmcnt(0)" ::: "memory");
        bf16_t* Tb = Tm + (size_t)it * 8192;
#pragma unroll
        for (int q = 0; q < 16; ++q) *(u32x4*)(Tb + (size_t)(lane + 64 * q) * 8) = *(const LAS u32x4*)(TL + (lane + 64 * q) * 8);
        GC[(size_t)it * 64 + lane] = gcl;
        asm volatile("s_waitcnt lgkmcnt(0)" ::: "memory");
    }
}

constexpr int G_QH = 0, G_KH = 17408, G_KT = 34816, G_VT = 53248, G_VS = 71680, G_TB = 90112, G_TG = 99328, G_QK = 108544, G_SB = 117760, G_SM = 152576;
__device__ __forceinline__ int tofs(int r, int c) { return (r * 72 + c) * 2; }
#define LFRAG(off) (*(const LAS bf16x8*)(L + (off)))
__device__ __forceinline__ void gdn_seq(const Params& p, lds_t L, int row0, int nchunks, int nvalid, int item0, int h, const float* Sin, float* Sout) {
    const bf16_t* P = (const bf16_t*)(p.ws + W_P); const bf16_t* QKV = (const bf16_t*)(p.ws + W_QKV);
    const bf16_t* Tm = (const bf16_t*)(p.ws + W_T); const float* GC = (const float*)(p.ws + W_GC); bf16_t* MG = (bf16_t*)(p.ws + W_MG);
    const int tid = ltid(), lane = tid & 63, wave = tid >> 6, l15 = lane & 15, lq = lane >> 4;
    LAS float* SM = (LAS float*)(L + G_SM);
    f32x4 accS[8];
#pragma unroll
    for (int kt = 0; kt < 8; ++kt) { accS[kt] = (f32x4){0.f, 0.f, 0.f, 0.f}; if (Sin) accS[kt] = *(const f32x4*)(Sin + (size_t)(16 * kt + l15) * 128 + 16 * wave + 4 * lq); }
    const float ng0 = p.in[10][2 * lane], ng1 = p.in[10][2 * lane + 1];
    u32x4 pq[2], pk[2], pv[2], ptb, ptg; float pgc, pgl;
    auto gload = [&](int c) {
        const int r0n = row0 + c * 64, itn = item0 + c * 8;
        int tl2 = tid; asm volatile("" : "+v"(tl2));
        const int ln = tl2 & 63, wv = tl2 >> 6;
#pragma unroll
        for (int e = 0; e < 2; ++e) { const int c8 = (wv * 2 + e) * 8;
            pq[e] = (u32x4){0u, 0u, 0u, 0u}; pk[e] = pq[e]; pv[e] = pq[e];
            if (ln < nvalid) { const bf16_t* src = QKV + (size_t)(r0n + ln) * 3072 + h * 128 + c8; pq[e] = *(const u32x4*)src; pk[e] = *(const u32x4*)(src + 1024); pv[e] = *(const u32x4*)(src + 2048); } }
        { const int row = tl2 >> 3, c8 = (tl2 & 7) * 8; const bf16_t* src = Tm + (size_t)itn * 8192 + row * 64 + c8; ptb = *(const u32x4*)src; ptg = *(const u32x4*)(src + 4096); }
        pgc = GC[(size_t)itn * 64 + ln]; pgl = GC[(size_t)itn * 64 + 63];
    };
    gload(0);
    for (int ck = 0; ck < nchunks; ++ck) {
        const int r0 = row0 + ck * 64, item = item0 + ck * 8;
        int tl_ = tid; asm volatile("" : "+v"(tl_));
        const int lane = tl_ & 63, wave = tl_ >> 6, l15 = lane & 15, lq = lane >> 4;
#pragma unroll
        for (int e = 0; e < 2; ++e) {
            const int row = lane, c8 = (wave * 2 + e) * 8;
            const u32x4 q = pq[e], k = pk[e], v = pv[e];
            *(LAS u32x4*)(L + G_QH + (row * 136 + c8) * 2) = q;
            *(LAS u32x4*)(L + G_KH + (row * 136 + c8) * 2) = k;
#pragma unroll
            for (int x = 0; x < 4; ++x) {
                *(LAS bf16_t*)(L + G_KT + tofs(c8 + 2 * x, row)) = (bf16_t)(k[x] & 0xffffu); *(LAS bf16_t*)(L + G_KT + tofs(c8 + 2 * x + 1, row)) = (bf16_t)(k[x] >> 16);
                *(LAS bf16_t*)(L + G_VT + tofs(c8 + 2 * x, row)) = (bf16_t)(v[x] & 0xffffu); *(LAS bf16_t*)(L + G_VT + tofs(c8 + 2 * x + 1, row)) = (bf16_t)(v[x] >> 16);
            }
        }
        { const int row = tid >> 3, c8 = (tid & 7) * 8;
          *(LAS u32x4*)(L + G_TB + (row * 72 + c8) * 2) = ptb; *(LAS u32x4*)(L + G_TG + (row * 72 + c8) * 2) = ptg; }
        if (tid < 64) { const float gcv = pgc, gl = pgl;
            SM[tid] = gcv; SM[64 + tid] = __expf(gcv); SM[128 + tid] = __expf(gl - gcv); if (tid == 0) SM[192] = __expf(gl); }
        if (ck + 1 < nchunks) gload(ck + 1);
        if (ck == 0) {
#pragma unroll
            for (int kt = 0; kt < 8; ++kt)
#pragma unroll
                for (int jj = 0; jj < 4; ++jj) *(LAS bf16_t*)(L + G_SB + ((16 * wave + 4 * lq + jj) * 136 + 16 * kt + l15) * 2) = f2bf(accS[kt][jj]);
        }
        lds_barrier();
        {
            const int tI = wave >> 1;
#pragma unroll
            for (int x = 0; x < 2; ++x) { const int tJ = 2 * (wave & 1) + x; f32x4 a = (f32x4){0.f, 0.f, 0.f, 0.f};
                if (tJ <= tI) {
#pragma unroll
                    for (int kk = 0; kk < 4; ++kk) a = mfma16(LFRAG(G_QH + ((16 * tI + l15) * 136 + kk * 32 + 8 * lq) * 2), LFRAG(G_KH + ((16 * tJ + l15) * 136 + kk * 32 + 8 * lq) * 2), a); }
#pragma unroll
                for (int jj = 0; jj < 4; ++jj) { const int i = 16 * tI + 4 * lq + jj, j = 16 * tJ + l15;
                    const float val = (i >= j) ? a[jj] * __expf(SM[i] - SM[j]) : 0.f;
                    *(LAS bf16_t*)(L + G_QK + (i * 72 + j) * 2) = f2bf(val); } }
        }
        f32x4 accU[4], accW[4];
#pragma unroll
        for (int ct = 0; ct < 4; ++ct) { accU[ct] = (f32x4){0.f, 0.f, 0.f, 0.f}; accW[ct] = accU[ct];
#pragma unroll
            for (int js = 0; js < 2; ++js) {
                accU[ct] = mfma16(LFRAG(G_VT + tofs(16 * wave + l15, js * 32 + 8 * lq)), LFRAG(G_TB + ((16 * ct + l15) * 72 + js * 32 + 8 * lq) * 2), accU[ct]);
                accW[ct] = mfma16(LFRAG(G_TG + ((16 * ct + l15) * 72 + js * 32 + 8 * lq) * 2), LFRAG(G_KT + tofs(16 * wave + l15, js * 32 + 8 * lq)), accW[ct]); }
            asm volatile("" ::: "memory"); }
        lds_barrier();
#pragma unroll
        for (int ct = 0; ct < 4; ++ct)
#pragma unroll
            for (int jj = 0; jj < 4; ++jj) *(LAS bf16_t*)(L + G_KH + ((16 * ct + 4 * lq + jj) * 136 + 16 * wave + l15) * 2) = f2bf(-accW[ct][jj]);
        lds_barrier();
        unsigned zz8[8], ga8[8];
#pragma unroll
        for (int q = 0; q < 8; ++q) { const int c = wave + 8 * q; zz8[q] = 0u; ga8[q] = 0u;
            if (c < nvalid) { const size_t row = (size_t)(r0 + c); const int col = h * 128 + 2 * lane; zz8[q] = *(const unsigned*)(P + row * NPAD + C_Z + col); ga8[q] = *(const unsigned*)(P + row * NPAD + C_GA + col); } }
        f32x4 accO[4];
        {
            bf16x8 sf[4];
#pragma unroll
            for (int ks = 0; ks < 4; ++ks) sf[ks] = LFRAG(G_SB + ((16 * wave + l15) * 136 + ks * 32 + 8 * lq) * 2);
#pragma unroll
            for (int ct = 0; ct < 4; ++ct) { accO[ct] = (f32x4){0.f, 0.f, 0.f, 0.f};
#pragma unroll
                for (int ks = 0; ks < 4; ++ks) {
                    accU[ct] = mfma16(sf[ks], LFRAG(G_KH + ((16 * ct + l15) * 136 + ks * 32 + 8 * lq) * 2), accU[ct]);
                    accO[ct] = mfma16(sf[ks], LFRAG(G_QH + ((16 * ct + l15) * 136 + ks * 32 + 8 * lq) * 2), accO[ct]); }
                const int c = 16 * ct + l15; const float ec = SM[128 + c], eg = SM[64 + c];
#pragma unroll
                for (int jj = 0; jj < 4; ++jj) { const int v = 16 * wave + 4 * lq + jj;
                    *(LAS bf16_t*)(L + G_VT + tofs(v, c)) = f2bf(accU[ct][jj]); *(LAS bf16_t*)(L + G_VS + tofs(v, c)) = f2bf(accU[ct][jj] * ec);
                    accO[ct][jj] *= eg; }
                asm volatile("" ::: "memory"); }
        }
        lds_barrier();
        {
            bf16x8 vf[2], vsf[2];
#pragma unroll
            for (int js = 0; js < 2; ++js) { vf[js] = LFRAG(G_VT + tofs(16 * wave + l15, js * 32 + 8 * lq)); vsf[js] = LFRAG(G_VS + tofs(16 * wave + l15, js * 32 + 8 * lq)); }
#pragma unroll
            for (int ct = 0; ct < 4; ++ct) {
#pragma unroll
                for (int js = 0; js < 2; ++js) accO[ct] = mfma16(vf[js], LFRAG(G_QK + ((16 * ct + l15) * 72 + js * 32 + 8 * lq) * 2), accO[ct]);
                *(LAS f32x4*)(L + ((16 * ct + l15) * 132 + 16 * wave + 4 * lq) * 4) = accO[ct];
                asm volatile("" ::: "memory"); }
            const float egl = SM[192];
#pragma unroll
            for (int kt = 0; kt < 8; ++kt) { accS[kt] = accS[kt] * egl;
#pragma unroll
                for (int js = 0; js < 2; ++js) accS[kt] = mfma16(vsf[js], LFRAG(G_KT + tofs(16 * kt + l15, js * 32 + 8 * lq)), accS[kt]);
#pragma unroll
                for (int jj = 0; jj < 4; ++jj) *(LAS bf16_t*)(L + G_SB + ((16 * wave + 4 * lq + jj) * 136 + 16 * kt + l15) * 2) = f2bf(accS[kt][jj]);
                asm volatile("" ::: "memory"); }
        }
        lds_barrier();
#pragma unroll
        for (int q = 0; q < 8; ++q) { const int c = wave + 8 * q;
            if (c < nvalid) {
                const f32x2 o = *(const LAS f32x2*)(L + (c * 132 + 2 * lane) * 4);
                const float ss = wave_sum(o[0] * o[0] + o[1] * o[1]); const float rinv = rsqrtf(ss * (1.f / 128.f) + 1e-6f);
                const size_t row = (size_t)(r0 + c); const int col = h * 128 + 2 * lane;
                const unsigned zz = zz8[q], ga = ga8[q];
                const float o0 = o[0] * rinv * ng0 * siluf(bflo(zz)) * sigm(bflo(ga)), o1 = o[1] * rinv * ng1 * siluf(bfhi(zz)) * sigm(bfhi(ga));
                *(unsigned*)(MG + row * 1024 + col) = cvt_pk_bf16(o0, o1); } }
        lds_barrier();
    }
    { int so = l15 * 128 + 16 * wave + 4 * lq; asm volatile("" : "+v"(so));
#pragma unroll
      for (int kt = 0; kt < 8; ++kt) *(f32x4*)(Sout + (size_t)(so + kt * 2048)) = accS[kt]; }
}
constexpr int R_OP = 57344, R_YB = 114688;
__device__ __forceinline__ void rwkv_seq(const Params& p, lds_t L, int s, int rbase, int T, bool samp, int b, int h, const float* Sin, float* Sout) {
    const bf16_t* P = (const bf16_t*)(p.ws + W_P); const bf16_t* LR = (const bf16_t*)(p.ws + W_L); bf16_t* MG = (bf16_t*)(p.ws + W_MG);
    const bf16_t* SC = (const bf16_t*)(p.ws + W_SC);
    const int tid = ltid(), lane = tid & 63, wave = tid >> 6;
    const int NT = (T + 15) / 16;
    const bool scanner = wave < 4;
    typedef float f32x16 __attribute__((ext_vector_type(16)));
    const int hh_s = wave >> 1, half = wave & 1, cl = lane & 31, hf = lane >> 5;
    f32x16 T0, T1;
    const int hh_l = wave & 1, st0 = (wave < 4) ? 3 * (wave >> 1) : 6 + 5 * ((wave - 4) >> 1);
    const int hg_s = 2 * h + hh_s;
    const int hg = 2 * h + hh_l;
    const int hc = hg * 64 + lane;
    const size_t lbase = samp ? ((size_t)MPR * 3072 + (size_t)((b * 8 + h) * NSS) * 384) : ((size_t)((b * 8 + h) * TS) * 384);
    float c_mur = 0.f, c_muk = 0.f, c_muv = 0.f, c_w0 = 0.f, c_a0 = 0.f, c_kk = 0.f, c_ka = 0.f, c_rk = 0.f, c_lg = 0.f, c_lb = 0.f, c_pr = 0.f, c_pk = 0.f, c_pv = 0.f;
    if (scanner) {
#pragma unroll
        for (int g = 0; g < 4; ++g) { f32x4 t0 = (f32x4){0.f, 0.f, 0.f, 0.f}, t1 = t0;
            if (Sin) { const float* sp = Sin + ((size_t)hg_s * 64 + 32 * half + cl) * 64 + 8 * g + 4 * hf; t0 = *(const f32x4*)sp; t1 = *(const f32x4*)(sp + 32); }
#pragma unroll
            for (int q = 0; q < 4; ++q) { T0[4 * g + q] = t0[q]; T1[4 * g + q] = t1[q]; } }
    }
    {
        if (samp) { c_pr = p.in[4][(size_t)b * CB + hc]; c_pk = p.in[4][(size_t)b * CB + 1024 + hc]; c_pv = p.in[4][(size_t)b * CB + 2048 + hc]; }
        else if (s > 0) { const bf16_t* sc = SC + ((size_t)((s & 1) * NB + b)) * CB; c_pr = bf2f(sc[hc]); c_pk = bf2f(sc[1024 + hc]); c_pv = bf2f(sc[2048 + hc]); }
    }
    typedef unsigned short us2 __attribute__((ext_vector_type(2)));
    struct RawA { us2 rk[6], vl[6], ll[6], q0, q1; };
    struct RawB { us2 go[6]; };
    auto issueA = [&](auto nqc, int nl, RawA& a) {
        constexpr int NQ = decltype(nqc)::value;
        const int tb = nl * 16 + st0;
#pragma unroll
        for (int q = 0; q < NQ; ++q) { const size_t row = (size_t)(rbase + tb + q); const bf16_t* Pr = P + row * NPAD + C_PB; const bf16_t* Lr = LR + lbase + (size_t)((tb + q) * 2 + hh_l) * 192 + lane;
            a.rk[q].x = Pr[hc]; a.rk[q].y = Pr[1024 + hc]; a.vl[q].x = Pr[2048 + hc]; a.vl[q].y = Lr[0]; a.ll[q].x = Lr[64]; a.ll[q].y = Lr[128]; }
        if (tb > 0) { const bf16_t* Pq = P + (size_t)(rbase + tb - 1) * NPAD + C_PB; a.q0.x = Pq[hc]; a.q0.y = Pq[1024 + hc]; a.q1.x = Pq[2048 + hc]; a.q1.y = 0; }
        else { a.q0.x = 0; a.q0.y = 0; a.q1.x = 0; a.q1.y = 1; }
    };
    auto issueB = [&](auto nqc, int np, RawB& bq) {
        constexpr int NQ = decltype(nqc)::value;
        const int tb = np * 16 + st0;
#pragma unroll
        for (int q = 0; q < NQ; ++q) { const size_t row = (size_t)(rbase + tb + q); bq.go[q].x = P[row * NPAD + C_GB + hc]; bq.go[q].y = MG[row * 1024 + hc]; }
    };
    auto postcalc = [&](auto nqc, int np, float (&outv)[6]) {
        constexpr int NQ = decltype(nqc)::value;
        int hl = hc; asm volatile("" : "+v"(hl));
        const float c_rk = p.in[19][hl], c_lg = p.in[20][hl], c_lb = p.in[21][hl];
        const LAS float* OP = (const LAS float*)(L + (np & 1) * R_OP); const LAS float* YB = (const LAS float*)(L + R_YB + (np & 1) * 8192);
        float y[NQ], m[NQ], bs[NQ], vq[NQ], gq[NQ];
#pragma unroll
        for (int q = 0; q < NQ; ++q) { const int tt = st0 + q; const LAS float* o = OP + ((hh_l * 16 + tt) * 7) * 64 + lane;
            y[q] = YB[(hh_l * 16 + tt) * 64 + lane]; m[q] = y[q]; bs[q] = o[256] * o[192] * c_rk; vq[q] = o[320]; gq[q] = o[384]; }
        wave_sumN<NQ>(m); wave_sumN<NQ>(bs);
        float d[NQ], var[NQ];
#pragma unroll
        for (int q = 0; q < NQ; ++q) { d[q] = y[q] - m[q] * (1.f / 64.f); var[q] = d[q] * d[q]; }
        wave_sumN<NQ>(var);
#pragma unroll
        for (int q = 0; q < NQ; ++q) { const float yn = d[q] * rsqrtf(var[q] * (1.f / 64.f) + 64e-5f) * c_lg + c_lb; outv[q] = (yn + bs[q] * vq[q]) * gq[q]; }
    };
    auto postwrite = [&](auto nqc, int np, const RawB& bq, const float (&outv)[6]) {
        constexpr int NQ = decltype(nqc)::value;
        const int tb = np * 16 + st0;
        float eg[NQ];
#pragma unroll
        for (int q = 0; q < NQ; ++q) eg[q] = __expf(-bf2f(bq.go[q].x));
#pragma unroll
        for (int q = 0; q < NQ; ++q) eg[q] = __builtin_amdgcn_rcpf(1.0f + eg[q]);
#pragma unroll
        for (int q = 0; q < NQ; ++q) { const size_t row = (size_t)(rbase + tb + q); MG[row * 1024 + hc] = f2bf(bf2f(bq.go[q].y) + eg[q] * outv[q]); }
    };
    auto transform = [&](auto nqc, int nl, const RawA& a) {
        constexpr int NQ = decltype(nqc)::value;
        LAS float* OP = (LAS float*)(L + (nl & 1) * R_OP);
        int hl = hc; asm volatile("" : "+v"(hl));
        const float c_mur = p.in[11][hl], c_muk = p.in[11][1024 + hl], c_muv = p.in[11][2048 + hl], c_w0 = p.in[12][hl], c_a0 = p.in[14][hl], c_kk = p.in[17][hl], c_ka = p.in[18][hl];
        float qr = c_pr, qk = c_pk, qv = c_pv;
        if (a.q1.y == 0) { qr = bf2f(a.q0.x); qk = bf2f(a.q0.y); qv = bf2f(a.q1.x); }
        float xr[NQ], xk[NQ], xv[NQ], kkv[NQ], ss[NQ], e1[NQ], e2[NQ];
#pragma unroll
        for (int q = 0; q < NQ; ++q) { const float pr = bf2f(a.rk[q].x), pk = bf2f(a.rk[q].y), pv = bf2f(a.vl[q].x);
            xr[q] = pr + c_mur * (qr - pr); xk[q] = pk + c_muk * (qk - pk); xv[q] = pv + c_muv * (qv - pv); qr = pr; qk = pk; qv = pv;
            kkv[q] = xk[q] * c_kk; ss[q] = kkv[q] * kkv[q]; }
        wave_sumN<NQ>(ss);
#pragma unroll
        for (int q = 0; q < NQ; ++q) { e1[q] = __expf(-(c_w0 + bf2f(a.vl[q].y))); e2[q] = __expf(-(c_a0 + bf2f(a.ll[q].x))); }
        float sw[NQ], asig[NQ], rn[NQ];
#pragma unroll
        for (int q = 0; q < NQ; ++q) { sw[q] = __builtin_amdgcn_rcpf(1.0f + e1[q]); asig[q] = __builtin_amdgcn_rcpf(1.0f + e2[q]); rn[q] = rsqrtf(ss[q] + 1e-6f); }
        float dec[NQ];
#pragma unroll
        for (int q = 0; q < NQ; ++q) dec[q] = __expf(-0.6065306597126334f * sw[q]);
#pragma unroll
        for (int q = 0; q < NQ; ++q) { const int tt = st0 + q; const float kk = kkv[q] * rn[q]; const float kmod = xk[q] * (1.f + (asig[q] - 1.f) * c_ka);
            LAS float* o = OP + ((hh_l * 16 + tt) * 7) * 64 + lane;
            o[0] = dec[q]; o[64] = -kk; o[128] = kk * asig[q]; o[192] = kmod; o[256] = xr[q]; o[320] = xv[q]; o[384] = bf2f(a.ll[q].y); }
    };
    auto scan_tile = [&](const LAS float* OP, LAS float* YB) {
        const int roff = 4 * hf;
        const int abase = (hf ? 192 : 128) + cl;
        for (int tt = 0; tt < 16; ++tt) {
            const LAS float* op = OP + ((hh_s * 16 + tt) * 7) * 64;
            f32x4 ar[2][4], wr[2][4];
#pragma unroll
            for (int jb = 0; jb < 2; ++jb)
#pragma unroll
                for (int g = 0; g < 4; ++g) { ar[jb][g] = *(const LAS f32x4*)(op + 64 + 32 * jb + 8 * g + roff); wr[jb][g] = *(const LAS f32x4*)(op + 32 * jb + 8 * g + roff); }
            const float aop0 = op[abase], aop1 = op[abase + 32], vv = op[320 + 32 * half + cl];
            f32x4 acc = (f32x4){0.f, 0.f, 0.f, 0.f}, acd = acc;
#pragma unroll
            for (int g = 0; g < 4; ++g) { const f32x4 t0 = (f32x4){T0[4 * g], T0[4 * g + 1], T0[4 * g + 2], T0[4 * g + 3]}, t1 = (f32x4){T1[4 * g], T1[4 * g + 1], T1[4 * g + 2], T1[4 * g + 3]};
                acc += t0 * ar[0][g]; acd += t1 * ar[1][g]; }
            acc += acd;
            const float part = (acc[0] + acc[1]) + (acc[2] + acc[3]);
            const float sa = part + __shfl_xor(part, 32);
            const float bop = hf ? vv : sa;
#pragma unroll
            for (int g = 0; g < 4; ++g)
#pragma unroll
                for (int q = 0; q < 4; ++q) { T0[4 * g + q] *= wr[0][g][q]; T1[4 * g + q] *= wr[1][g][q]; }
            T0 = __builtin_amdgcn_mfma_f32_32x32x2f32(aop0, bop, T0, 0, 0, 0);
            T1 = __builtin_amdgcn_mfma_f32_32x32x2f32(aop1, bop, T1, 0, 0, 0);
            f32x4 yc = (f32x4){0.f, 0.f, 0.f, 0.f}, yd = yc;
#pragma unroll
            for (int g = 0; g < 4; ++g) { const f32x4 r0 = *(const LAS f32x4*)(op + 256 + 8 * g + roff), r1 = *(const LAS f32x4*)(op + 256 + 32 + 8 * g + roff);
                const f32x4 t0 = (f32x4){T0[4 * g], T0[4 * g + 1], T0[4 * g + 2], T0[4 * g + 3]}, t1 = (f32x4){T1[4 * g], T1[4 * g + 1], T1[4 * g + 2], T1[4 * g + 3]};
                yc += t0 * r0; yd += t1 * r1; }
            yc += yd;
            const float yp = (yc[0] + yc[1]) + (yc[2] + yc[3]);
            const float y = yp + __shfl_xor(yp, 32);
            if (hf == 0) YB[(hh_s * 16 + tt) * 64 + 32 * half + cl] = y;
        }
    };
    auto work = [&](auto nqc, int n, RawA& Acur, RawA& Anext) {
        RawB Bq; float outv[6];
        if (n >= 1) issueB(nqc, n - 1, Bq);
        if (n + 2 < NT) issueA(nqc, n + 2, Anext);
        if (scanner) { const LAS float* OP = (const LAS float*)(L + (n & 1) * R_OP); LAS float* YB = (LAS float*)(L + R_YB + (n & 1) * 8192); scan_tile(OP, YB); }
        if (n >= 1) postcalc(nqc, n - 1, outv);
        if (n + 1 < NT) transform(nqc, n + 1, Acur);
        if (n >= 1) postwrite(nqc, n - 1, Bq, outv);
    };
    auto iter = [&](int n, RawA& Acur, RawA& Anext) {
        if (scanner) work(IC<3>{}, n, Acur, Anext); else work(IC<5>{}, n, Acur, Anext);
        lds_barrier();
    };
    RawA A0, A1;
    if (scanner) { issueA(IC<3>{}, 0, A1); transform(IC<3>{}, 0, A1); if (NT > 1) issueA(IC<3>{}, 1, A0); }
    else { issueA(IC<5>{}, 0, A1); transform(IC<5>{}, 0, A1); if (NT > 1) issueA(IC<5>{}, 1, A0); }
    __syncthreads();
    for (int n = 0; n < NT; n += 2) {
        iter(n, A0, A1);
        if (n + 1 < NT) iter(n + 1, A1, A0);
    }
    { RawB Bq; float outv[6];
      if (scanner) { issueB(IC<3>{}, NT - 1, Bq); postcalc(IC<3>{}, NT - 1, outv); postwrite(IC<3>{}, NT - 1, Bq, outv); }
      else { issueB(IC<5>{}, NT - 1, Bq); postcalc(IC<5>{}, NT - 1, outv); postwrite(IC<5>{}, NT - 1, Bq, outv); } }
    if (scanner) {
#pragma unroll
        for (int g = 0; g < 4; ++g) { float* sp = Sout + ((size_t)hg_s * 64 + 32 * half + cl) * 64 + 8 * g + 4 * hf;
            *(f32x4*)sp = (f32x4){T0[4 * g], T0[4 * g + 1], T0[4 * g + 2], T0[4 * g + 3]}; *(f32x4*)(sp + 32) = (f32x4){T1[4 * g], T1[4 * g + 1], T1[4 * g + 2], T1[4 * g + 3]}; }
    }
    __syncthreads();
}

__device__ __forceinline__ void ph_seq(const Params& p, lds_t L, int s) {
    for (int blk = blockIdx.x; blk < NB * 8; blk += gridDim.x) {
        const int b = blk >> 3, h = blk & 7;
        float* gst = p.out + O_GP + ((size_t)(b * 8 + h)) * 16384;
#ifndef NO_GDN
        gdn_seq(p, L, b * TS, TS / 64, 64, (b << 6) + h, h, s > 0 ? gst : nullptr, gst);
#endif
        float* wst = p.out + O_WP + (size_t)b * 16 * 4096;
#ifndef NO_RWKV
        rwkv_seq(p, L, s, b * TS, TS, false, b, h, s > 0 ? wst : nullptr, wst);
#endif
    }
#ifndef NO_SAMP
    if (s == 0) for (int blk = blockIdx.x; blk < NSB * 8; blk += gridDim.x) {
        const int sb = blk >> 3, h = blk & 7;
        gdn_seq(p, L, MPR + sb * NSS, 1, NSS, NITEM_P + blk, h, p.in[3] + ((size_t)(sb * 8 + h)) * 16384, p.out + O_GS + ((size_t)(sb * 8 + h)) * 16384);
        rwkv_seq(p, L, s, MPR + sb * NSS, NSS, true, sb, h, p.in[5] + (size_t)sb * 16 * 4096, p.out + O_WS + (size_t)sb * 16 * 4096);
    }
#endif
}

#ifdef ONLY
#define EN(x) ((x) == ONLY)
#elif defined(ENMASK)
#define EN(x) (((ENMASK) >> ((x) == 100 ? 11 : (x))) & 1)
#else
#define EN(x) true
#endif

template <int MODE> __device__ __forceinline__ void skinny_gemm(const Params& p, lds_t L, const bf16_t* A, int lda, const bf16_t* Bt, int ldb, int N, int K) {
    const int tid = ltid(), lane = tid & 63, wave = tid >> 6, l15 = lane & 15, lq = lane >> 4;
    LAS float* red = (LAS float*)L;
    const int ntile = 8 * (N / 16), kw = K / 8;
    float* PL = (float*)(p.ws + W_PL); bf16_t* Fb = (bf16_t*)(p.ws + W_P);
    for (int t = blockIdx.x; t < ntile; t += gridDim.x) {
        const int tr = t & 7, tc = t >> 3;
        const bf16_t* ap = A + (size_t)(16 * tr + l15) * lda + wave * kw + 8 * lq;
        const bf16_t* bp = Bt + (size_t)(16 * tc + l15) * ldb + wave * kw + 8 * lq;
        f32x4 acc = (f32x4){0.f, 0.f, 0.f, 0.f};
        for (int k0 = 0; k0 < kw; k0 += 128) {
            u32x4 af[4], bf[4];
#pragma unroll
            for (int u = 0; u < 4; ++u) { af[u] = *(const u32x4*)(ap + k0 + 32 * u); bf[u] = *(const u32x4*)(bp + k0 + 32 * u); }
#pragma unroll
            for (int u = 0; u < 4; ++u) acc = mfma16(__builtin_bit_cast(bf16x8, af[u]), __builtin_bit_cast(bf16x8, bf[u]), acc);
        }
#pragma unroll
        for (int jj = 0; jj < 4; ++jj) red[wave * 256 + (4 * lq + jj) * 16 + l15] = acc[jj];
        __syncthreads();
        if (tid < 256) {
            float v = 0.f;
#pragma unroll
            for (int w = 0; w < 8; ++w) v += red[w * 256 + tid];
            const int r = 16 * tr + (tid >> 4), c = 16 * tc + (tid & 15); const size_t row = (size_t)(MPR + r);
            if (MODE == 0) PL[row * 1024 + c] = v + DN_ALPHA * p.in[1][(size_t)r * D + c];
            else if (MODE == 1) { const float a = fmaxf(v, 0.f); Fb[row * LDF + c] = f2bf(a * a); }
            else PL[row * 1024 + c] = v + DN_ALPHA * PL[row * 1024 + c];
        }
        __syncthreads();
    }
}
#define XB_TMO      128
#define XB_XCNT(j)  (256  + 64 * (j))
#define XB_XSUB(j)  (1280 + 64 * (j))
#define XB_XGEN(j)  (2304 + 64 * (j))
#define XB_TOP      3328
#define XB_TOPGEN   3392
#define XCD_BAR_WORDS 3456
#define XB_SPIN_CAP (1u << 20)
__device__ __forceinline__ unsigned xb_ld(unsigned* p)              { return __hip_atomic_load(p, __ATOMIC_RELAXED, __HIP_MEMORY_SCOPE_AGENT); }
__device__ __forceinline__ unsigned xb_add(unsigned* p, unsigned v) { return __hip_atomic_fetch_add(p, v, __ATOMIC_RELAXED, __HIP_MEMORY_SCOPE_AGENT); }
__device__ __forceinline__ unsigned xb_xcc_id() { return (unsigned)__builtin_amdgcn_s_getreg((3 << 11) | 20) & 0xFu; }
#define XB_SPIN(cond, bar) do { unsigned _sp = 0; while (cond) { __builtin_amdgcn_s_sleep(1); \
    if ((++_sp & 255u) == 0u) { if (xb_ld(&(bar)[XB_TMO])) break; if (_sp > XB_SPIN_CAP) { atomicAdd(&(bar)[XB_TMO], 1u); break; } } } } while (0)
struct XcdBarrier { unsigned* bar; unsigned x; volatile LAS unsigned* st; };
__device__ __forceinline__ XcdBarrier xcd_barrier_post(unsigned* bar, volatile LAS unsigned* st) {
    XcdBarrier b; b.bar = bar; b.x = xb_xcc_id(); b.st = st;
    if (threadIdx.x == 0) (void)xb_add(&bar[XB_XCNT(b.x)], 1u);
    return b;
}
__device__ __forceinline__ void xcd_barrier_complete(unsigned* bar, unsigned x, unsigned& nloc, unsigned& nx) {
    const unsigned G = gridDim.x * gridDim.y * gridDim.z;
    unsigned sum, cnt, mine, sp = 0u;
    for (;;) {
        sum = 0u; cnt = 0u; mine = 0u;
#pragma unroll
        for (unsigned j = 0; j < 16; ++j) { const unsigned c = xb_ld(&bar[XB_XCNT(j)]); sum += c; cnt += (c > 0u) ? 1u : 0u; mine = (j == x) ? c : mine; }
        if (sum == G) break;
        __builtin_amdgcn_s_sleep(1);
        if ((++sp & 255u) == 0u) { if (xb_ld(&bar[XB_TMO])) break; if (sp > XB_SPIN_CAP) { atomicAdd(&bar[XB_TMO], 1u); break; } }
    }
    nloc = mine > 0u ? mine : 1u; nx = cnt > 0u ? cnt : 1u;
}
__device__ __forceinline__ void xcd_barrier(const XcdBarrier& b) {
    asm volatile("s_waitcnt vmcnt(0)" ::: "memory");
    __syncthreads();
    if (threadIdx.x == 0) {
        unsigned* bar = b.bar;
        __builtin_amdgcn_s_waitcnt(0);
        unsigned nloc = b.st[0], nx = b.st[1];
        if (nloc == 0u) { xcd_barrier_complete(bar, b.x, nloc, nx); b.st[0] = nloc; b.st[1] = nx; }
        const unsigned old = xb_add(&bar[XB_XSUB(b.x)], 1u);
        const unsigned gen = old / nloc;
        if (old + 1u == (gen + 1u) * nloc) {
            __builtin_amdgcn_fence(__ATOMIC_RELEASE, "agent");
            asm volatile("s_waitcnt vmcnt(0)" ::: "memory");
            const unsigned og = xb_add(&bar[XB_TOP], 1u);
            const unsigned tg = og / nx;
            if (og + 1u == (tg + 1u) * nx) xb_add(&bar[XB_TOPGEN], 1u);
            else XB_SPIN(xb_ld(&bar[XB_TOPGEN]) == tg, bar);
            __builtin_amdgcn_fence(__ATOMIC_ACQUIRE, "agent");
            xb_add(&bar[XB_XGEN(b.x)], 1u);
            asm volatile("s_waitcnt vmcnt(0)" ::: "memory");
        } else {
            XB_SPIN(xb_ld(&bar[XB_XGEN(b.x)]) == gen, bar);
            __builtin_amdgcn_fence(__ATOMIC_ACQUIRE, "agent");
            asm volatile("s_waitcnt vmcnt(0)" ::: "memory");
        }
    }
    __syncthreads();
}
constexpr int PPS = 8;
constexpr int NPHASE = 1 + NSEG * PPS + 1;
__global__ __launch_bounds__(512, 2) void mega(Params p) {
    extern __shared__ __attribute__((aligned(16))) unsigned char shm[];
    lds_t L = (lds_t)shm;
    cg::grid_group grid = cg::this_grid();
    volatile LAS unsigned* st = (volatile LAS unsigned*)(L + (LDS_BYTES - 16));
    if (threadIdx.x == 0) { st[0] = 0u; st[1] = 0u; }
    __syncthreads();
    const XcdBarrier xb = xcd_barrier_post((unsigned*)(p.ws + W_BAR), st);
    int redone = 0;
    for (int ph = p.ph_lo; ph < p.ph_hi; ++ph) {
        if (ph == 0) ph_wprep(p, L);
        else if (ph == NPHASE - 1) ph_ln<1>(p, NSEG - 1);
        else {
            const int s = (ph - 1) / PPS, k = (ph - 1) % PPS;
            const int mps = (s == 0) ? MP : MPR;
            if (k == 0 || k == 2) {
                if (k == 0 && s > 0) ph_ln<1>(p, s - 1);
                pg8::Gemm g; EpiB16<0> E;
                if (k == 0) { g.A = (const bf16_t*)(p.ws + W_XB) + xb_row0(s) * 1024; g.Bt = (const bf16_t*)(p.ws + W_WIN); g.M = mps; g.N = NPAD; g.K = 1024; g.lda = 1024; g.ldb = 1024; E.O = (bf16_t*)(p.ws + W_P); E.ldc = NPAD; E.hm = 0; }
                else { g.A = (const bf16_t*)(p.ws + W_LA); g.Bt = (const bf16_t*)(p.ws + W_WLORA); g.M = mps; g.N = 3072; g.K = 256; g.lda = 256; g.ldb = 256; E.O = (bf16_t*)(p.ws + W_L); E.ldc = 3072; E.hm = 1; }
                pg8::StaticOrder S; S.init(g.M, g.N, (int)gridDim.x, (int)blockIdx.x);
                pg8::gemm_phase<EpiB16<0>, pg8::StaticOrder, false>(L, g, S, E, nullptr);
                if (k == 2) { __syncthreads(); ph_gdnpre(p, L, s); }
            }
            else if (k == 1) ph_prep(p, s);
            else if (k == 3) ph_seq(p, L, s);
            else if (k == 4 || k == 7) {
                pg8::Gemm g; EpiAdd E; E.C = (float*)(p.ws + W_PL); E.xp = p.in[0]; E.xs = p.in[1]; E.s = s;
                if (k == 4) { g.A = (const bf16_t*)(p.ws + W_MG); g.Bt = (const bf16_t*)(p.ws + W_WOUT); g.M = MPR; g.N = 1024; g.K = 1024; g.lda = 1024; g.ldb = 1024; E.mode = 0; }
                else { g.A = (const bf16_t*)(p.ws + W_P); g.Bt = (const bf16_t*)(p.ws + W_WFF2); g.M = MPR; g.N = 1024; g.K = 4096; g.lda = LDF; g.ldb = LDF; E.mode = 1; }
                pg8::StaticOrder S; S.init(g.M, g.N, (int)gridDim.x, (int)blockIdx.x);
                pg8::gemm_phase<EpiAdd, pg8::StaticOrder, false>(L, g, S, E, nullptr);
                if (s == 0) { __syncthreads();
                    if (k == 4) skinny_gemm<0>(p, L, (const bf16_t*)(p.ws + W_MG) + (size_t)MPR * 1024, 1024, (const bf16_t*)(p.ws + W_WOUT), 1024, 1024, 1024);
                    else skinny_gemm<2>(p, L, (const bf16_t*)(p.ws + W_P) + (size_t)MPR * LDF, LDF, (const bf16_t*)(p.ws + W_WFF2), LDF, 1024, 4096); }
            }
            else if (k == 5) ph_ln<0>(p, s);
            else {
                pg8::Gemm g; EpiB16<1> E; g.A = (const bf16_t*)(p.ws + W_HB); g.Bt = (const bf16_t*)(p.ws + W_WFF1); g.M = MPR; g.N = 4096; g.K = 1024; g.lda = 1024; g.ldb = 1024; E.O = (bf16_t*)(p.ws + W_P); E.ldc = LDF; E.hm = 0;
                pg8::StaticOrder S; S.init(g.M, g.N, (int)gridDim.x, (int)blockIdx.x);
                pg8::gemm_phase<EpiB16<1>, pg8::StaticOrder, false>(L, g, S, E, nullptr);
                if (s == 0) { __syncthreads(); skinny_gemm<1>(p, L, (const bf16_t*)(p.ws + W_HB) + (size_t)MPR * 1024, 1024, (const bf16_t*)(p.ws + W_WFF1), 1024, 4096, 1024); }
            }
        }
        if (ph + 1 < p.ph_hi) { if (p.rep_mask == 0x7fffffff) grid.sync();   xcd_barrier(xb); }
        if ((p.rep_mask & 0x100000) && ph >= 1 && ph < NPHASE - 1 && ((ph - 1) % PPS) == 2 && !((redone >> ((ph - 1) / PPS)) & 1)) { redone |= 1 << ((ph - 1) / PPS); ph -= 3; }
    }
}

#ifndef REP_MASK
#define REP_MASK 0
#endif
extern "C" void kernel_launch(void* const* d_in, const int* in_sizes, int n_in, void* d_out, int out_size, void* d_ws, size_t ws_size, hipStream_t stream) {
    static int grid = 0;
    if (grid == 0) {
        int dev = 0, cus = 0, per_cu = 0;
        hipGetDevice(&dev);
        hipDeviceGetAttribute(&cus, hipDeviceAttributeMultiprocessorCount, dev);
        if (hipFuncSetAttribute((const void*)mega, hipFuncAttributeMaxDynamicSharedMemorySize, LDS_BYTES) != hipSuccess) { fprintf(stderr, "hipFuncSetAttribute failed\n"); }
        if (hipOccupancyMaxActiveBlocksPerMultiprocessor(&per_cu, (const void*)mega, 512, LDS_BYTES) != hipSuccess || per_cu < 1) { fprintf(stderr, "occupancy query: %d\n", per_cu); per_cu = 1; }
        (void)hipGetLastError();
        grid = cus * 1;
        if (ws_size < W_END) { fprintf(stderr, "workspace too small: %zu < %zu\n", ws_size, (size_t)W_END); grid = -1; }
    }
    if (grid < 0) return;
    (void)hipMemsetAsync((unsigned char*)d_ws + W_BAR, 0, 16384, stream);
    Params p{};
    for (int i = 0; i < 29; ++i) p.in[i] = (const float*)d_in[i];
    p.out = (float*)d_out; p.ws = (unsigned char*)d_ws; p.rep_mask = REP_MASK;
#if defined(MK_MULTI)
    for (int ph = 0; ph < NPHASE; ++ph) { p.ph_lo = ph; p.ph_hi = ph + 1; hipLaunchKernelGGL(mega, dim3(grid), dim3(512), LDS_BYTES, stream, p); }
#else
    p.ph_lo = 0; p.ph_hi = NPHASE;
    void* args[] = {&p};
    hipError_t e = hipLaunchCooperativeKernel((const void*)mega, dim3(grid), dim3(512), args, LDS_BYTES, stream);
    if (e != hipSuccess) fprintf(stderr, "cooperative launch failed: %s (grid %d)\n", hipGetErrorString(e), grid);
#endif
}
```

```cpp
#include <hip/hip_runtime.h>
#include <hip/hip_cooperative_groups.h>
#include <cstdio>
namespace cg = cooperative_groups;
namespace pg8 {
#define PG8_LAS __attribute__((address_space(3)))
typedef unsigned short bf16_t;
typedef short bf16x8 __attribute__((ext_vector_type(8)));
typedef float f32x4 __attribute__((ext_vector_type(4)));
typedef unsigned u32x4 __attribute__((ext_vector_type(4)));
constexpr int BM = 256, BK = 64, HALF = 128, HTB = HALF * BK * 2  , STAGE_BYTES = 8 * HTB, NXCD = 8, WGM = 8;

__host__ __device__ __forceinline__ int lds_byte(int r, int c) { const int st = (r >> 4) * 2 + (c >> 5), rr = r & 15, cc = c & 31, ob = rr * 64 + cc * 2; return st * 1024 + (ob ^ (((ob >> 9) & 1) << 5)); }
__host__ __device__ __forceinline__ void stage_rc(int b, int& R, int& C) { const int st = b / 1024, sb = b % 1024, swz = sb ^ (((sb >> 9) & 1) << 5); R = (st >> 1) * 16 + swz / 64; C = (st & 1) * 32 + (swz % 64) / 2; }
__host__ __device__ __forceinline__ int perm32(int rho) { const int n = rho >> 4, i = rho & 15; return 8 * (i >> 2) + 4 * n + (i & 3); }

struct Unit { int pm, pn; };
struct Gemm { const bf16_t* A; const bf16_t* Bt; int M, N, K; int lda, ldb; };

struct StaticOrder {
    int nM, nN, nwg, G, c;
    __host__ __device__ void init(int M, int N, int G_, int c_) { nM = M / BM; nN = N / BM; nwg = nM * nN; G = G_; c = c_; }
    __host__ __device__ bool next(int i, Unit& u) const {
        const long L = (long)i * G + c; if (L >= nwg) return false;
        int wgid = (int)L; { const int q = nwg / NXCD, r = nwg % NXCD, xcd = wgid % NXCD, off = wgid / NXCD; wgid = (xcd < r ? xcd * (q + 1) : r * (q + 1) + (xcd - r) * q) + off; }
        const int nig = WGM * nN, gid = wgid / nig, fm = gid * WGM, gsz = (nM - fm) < WGM ? (nM - fm) : WGM;
        u.pm = fm + ((wgid % nig) % gsz); u.pn = (wgid % nig) / gsz; return true;
    }
    __device__ __forceinline__ void a_ready(const Unit&) const {}
    __device__ __forceinline__ void done(const Unit&) const {}
};
typedef float f32x2c __attribute__((ext_vector_type(2)));
typedef __bf16 bf16v2c __attribute__((ext_vector_type(2)));
__device__ __forceinline__ unsigned cvt_pk_bf16(float lo, float hi) { f32x2c f = {lo, hi}; bf16v2c v = __builtin_convertvector(f, bf16v2c); return __builtin_bit_cast(unsigned, v); }
template <class Epi, class Sched, bool STAMP = false>
__device__ __forceinline__ void gemm_phase(PG8_LAS unsigned char* lds, const Gemm g, const Sched& S, const Epi& E, unsigned long long* stamps) {
    int tid_l = threadIdx.x; asm volatile("" : "+v"(tid_l)); const int tid = tid_l, wid = __builtin_amdgcn_readfirstlane(tid >> 6), lane = tid & 63, wr = wid >> 2, wc = wid & 3, fr = lane & 15, fq = lane >> 4;
    const int K = g.K, nt = K / BK;
    int ts_lo = 0, ts_hi = 0, nts = 0; const unsigned long long rt_entry = STAMP ? (unsigned long long)wall_clock64() : 0ull;
#define PG8_STAMP() do { if (STAMP && wid == 0 && nts < 64) { const unsigned long long _c = (unsigned long long)clock64(); \
        ts_lo = (lane == nts) ? (int)(unsigned)_c : ts_lo; ts_hi = (lane == nts) ? (int)(unsigned)(_c >> 32) : ts_hi; ++nts; } } while (0)
    PG8_STAMP();
    unsigned voffA[2], voffB[2];
#pragma unroll
    for (int i = 0; i < 2; ++i) { int R, C; stage_rc(tid * 16 + i * 8192, R, C); const int Rb = Epi::PERM ? ((R & ~31) + perm32(R & 31)) : R;
        voffA[i] = (unsigned)(R * g.lda + C) * 2u; voffB[i] = (unsigned)(Rb * g.ldb + C) * 2u; }
    const size_t kstep = (size_t)(BK * 2);
    const size_t hstepA = (size_t)HALF * g.lda * 2, hstepB = (size_t)HALF * g.ldb * 2;
    const size_t tstepA = 2 * hstepA, tstepB = 2 * hstepB;
    const unsigned ldsw = (unsigned)wid * 1024u;
    const int aoff = lds_byte(wr * 64 + fr, fq * 8), boff = lds_byte(wc * 32 + fr, fq * 8);
#define PG8_SA(b, h) (((b) * 2 + (h)) * HTB)
#define PG8_SB(b, h) ((4 + (b) * 2 + (h)) * HTB)
#define PG8_STAGE(bufoff, gbase, voff) do { _Pragma("unroll") for (int _i = 0; _i < 2; ++_i) \
        __builtin_amdgcn_global_load_lds((const unsigned*)((const char*)(gbase) + (voff)[_i]), (PG8_LAS unsigned*)(lds + (bufoff) + ldsw + _i * 8192), 16, 0, 0); } while (0)
#define PG8_LDA(dst, b, h) do { _Pragma("unroll") for (int m = 0; m < 4; ++m) _Pragma("unroll") for (int k = 0; k < 2; ++k) dst[m][k] = *(const PG8_LAS bf16x8*)(lds + PG8_SA(b, h) + aoff + m * 2048 + k * 1024); } while (0)
#define PG8_LDB(dst, b, h) do { _Pragma("unroll") for (int n = 0; n < 2; ++n) _Pragma("unroll") for (int k = 0; k < 2; ++k) dst[n][k] = *(const PG8_LAS bf16x8*)(lds + PG8_SB(b, h) + boff + n * 2048 + k * 1024); } while (0)
#define PG8_MMA(ai, bj, At, Bt) do { __builtin_amdgcn_s_setprio(1); _Pragma("unroll") for (int m = 0; m < 4; ++m) _Pragma("unroll") for (int n = 0; n < 2; ++n) _Pragma("unroll") for (int k = 0; k < 2; ++k) \
        acc[ai][bj][m][n] = __builtin_amdgcn_mfma_f32_16x16x32_bf16(Bt[n][k], At[m][k], acc[ai][bj][m][n], 0, 0, 0); __builtin_amdgcn_s_setprio(0); } while (0)
#define PG8_WAIT_V(n) asm volatile("s_waitcnt vmcnt(" #n ")" ::: "memory")
#define PG8_WAIT_L(n) asm volatile("s_waitcnt lgkmcnt(" #n ")" ::: "memory")
#define PG8_BAR __builtin_amdgcn_s_barrier()
#define PG8_SCHED __builtin_amdgcn_sched_barrier(0)
    Unit cur, nxt; int ui = 0;
    if (!S.next(0, cur)) return;
    f32x4 acc[2][2][4][2];
#pragma unroll
    for (int a = 0; a < 2; ++a)
#pragma unroll
        for (int b = 0; b < 2; ++b)
#pragma unroll
            for (int m = 0; m < 4; ++m)
#pragma unroll
                for (int n = 0; n < 2; ++n) acc[a][b][m][n] = (f32x4){0.f, 0.f, 0.f, 0.f};
    bf16x8 At[4][2], B0[2][2], B1[2][2];
    const char* cA = (const char*)g.A + (size_t)cur.pm * tstepA; const char* cB = (const char*)g.Bt + (size_t)cur.pn * tstepB;
    S.a_ready(cur);
    PG8_STAGE(PG8_SB(0, 0), cB, voffB); PG8_STAGE(PG8_SA(0, 0), cA, voffA); PG8_STAGE(PG8_SB(0, 1), cB + hstepB, voffB); PG8_STAGE(PG8_SA(0, 1), cA + hstepA, voffA);
    if (wr == 1) PG8_BAR;
    PG8_WAIT_V(4); PG8_BAR;
    PG8_STAGE(PG8_SB(1, 0), cB + kstep, voffB); PG8_STAGE(PG8_SA(1, 0), cA + kstep, voffA); PG8_STAGE(PG8_SB(1, 1), cB + hstepB + kstep, voffB);
    PG8_WAIT_V(6); PG8_BAR;
    PG8_STAMP();
    for (;;) {
        const bool has_next = S.next(ui + 1, nxt);
        const char* nA = has_next ? (const char*)g.A + (size_t)nxt.pm * tstepA : cA; const char* nB = has_next ? (const char*)g.Bt + (size_t)nxt.pn * tstepB : cB;
        for (int t = 0; t < nt; t += 2) {
            const bool last = (t == nt - 2);
            const char* a1 = cA + (size_t)(t + 1) * kstep;
            const char* a2 = last ? nA : cA + (size_t)(t + 2) * kstep; const char* b2 = last ? nB : cB + (size_t)(t + 2) * kstep;
            const char* a3 = a2 + kstep; const char* b3 = b2 + kstep;
            if (last && has_next) S.a_ready(nxt);
            PG8_LDB(B0, 0, 0); PG8_SCHED; PG8_LDA(At, 0, 0); PG8_STAGE(PG8_SA(1, 1), a1 + hstepA, voffA);
            PG8_WAIT_L(8); PG8_BAR; PG8_WAIT_L(0); PG8_MMA(0, 0, At, B0); PG8_BAR; PG8_SCHED;
            PG8_LDB(B1, 0, 1); PG8_STAGE(PG8_SB(0, 0), b2, voffB);
            PG8_BAR; PG8_WAIT_L(0); PG8_MMA(0, 1, At, B1); PG8_BAR;
            PG8_LDA(At, 0, 1); PG8_STAGE(PG8_SA(0, 0), a2, voffA);
            PG8_BAR; PG8_WAIT_L(0); PG8_MMA(1, 0, At, B0); PG8_BAR; PG8_SCHED;
            PG8_STAGE(PG8_SB(0, 1), b2 + hstepB, voffB);
            PG8_WAIT_V(6); PG8_BAR; PG8_MMA(1, 1, At, B1); PG8_BAR;
            PG8_LDB(B0, 1, 0); PG8_SCHED; PG8_LDA(At, 1, 0); PG8_STAGE(PG8_SA(0, 1), a2 + hstepA, voffA);
            PG8_WAIT_L(8); PG8_BAR; PG8_WAIT_L(0); PG8_MMA(0, 0, At, B0); PG8_BAR; PG8_SCHED;
            PG8_LDB(B1, 1, 1); PG8_STAGE(PG8_SB(1, 0), b3, voffB);
            PG8_BAR; PG8_WAIT_L(0); PG8_MMA(0, 1, At, B1); PG8_BAR;
            PG8_LDA(At, 1, 1); PG8_STAGE(PG8_SA(1, 0), a3, voffA);
            PG8_BAR; PG8_WAIT_L(0); PG8_MMA(1, 0, At, B0); PG8_BAR; PG8_SCHED;
            PG8_STAGE(PG8_SB(1, 1), b3 + hstepB, voffB);
            PG8_WAIT_V(6); PG8_BAR; PG8_MMA(1, 1, At, B1); PG8_BAR;
        }
        PG8_STAMP();
        if constexpr (!Epi::AFTER_DRAIN) { E(acc, cur, wr, wc, fr, fq); S.done(cur); }
        PG8_STAMP();
        if (!has_next) break;
#pragma unroll
        for (int a = 0; a < 2; ++a)
#pragma unroll
            for (int b = 0; b < 2; ++b)
#pragma unroll
                for (int m = 0; m < 4; ++m)
#pragma unroll
                    for (int n = 0; n < 2; ++n) acc[a][b][m][n] = (f32x4){0.f, 0.f, 0.f, 0.f};
        cur = nxt; cA = nA; cB = nB; ++ui;
    }
    PG8_WAIT_V(0);
    if (wr == 0) PG8_BAR;
    PG8_BAR;
    if constexpr (Epi::AFTER_DRAIN) { E.fused(acc, cur, wr, wc, fr, fq, lds, wid, lane); S.done(cur); }
    PG8_STAMP();
    if (STAMP && wid == 0) { stamps[lane] = lane < nts ? (((unsigned long long)(unsigned)ts_hi << 32) | (unsigned)ts_lo) : 0ull;
        if (lane == 62) stamps[62] = rt_entry; if (lane == 63) stamps[63] = (unsigned long long)wall_clock64(); }
#undef PG8_STAMP
#undef PG8_SA
#undef PG8_SB
#undef PG8_STAGE
#undef PG8_LDA
#undef PG8_LDB
#undef PG8_MMA
#undef PG8_WAIT_V
#undef PG8_WAIT_L
#undef PG8_BAR
#undef PG8_SCHED
}
}
using pg8::bf16_t; using pg8::bf16x8; using pg8::f32x4; using pg8::u32x4; using pg8::cvt_pk_bf16;
typedef float f32x2 __attribute__((ext_vector_type(2)));
typedef unsigned u32x2 __attribute__((ext_vector_type(2)));
#define LAS __attribute__((address_space(3)))
typedef LAS unsigned char* lds_t;

constexpr int D = 1024, NB = 32, SEQ = 2048, NSB = 8, NSS = 16;
constexpr int TS = 512, NSEG = SEQ / TS;
constexpr int MPR = NB * TS;
constexpr int MP = MPR + 256;
constexpr int NSAMP = NSB * NSS;
constexpr int NPAD = 9728, COLS = 9488;
constexpr int C_Z = 3072, C_BETA = 4096, C_AR = 4104, C_PB = 4112, C_GA = 7440, C_GB = 8464, CB = 3328;
constexpr float DN_ALPHA = 1.189207115002721f;
constexpr int LDS_BYTES = 163840;
constexpr int LDF = 4096 + 64;
constexpr int NITEM_P = NB * (TS / 64) * 8;
constexpr int NITEM = NITEM_P + 64;

constexpr size_t O_YP = 0, O_YS = O_YP + (size_t)NB * SEQ * D, O_CP = O_YS + (size_t)NSAMP * D, O_GP = O_CP + (size_t)NB * 3 * 3072,
    O_SP = O_GP + (size_t)NB * 8 * 16384, O_WP = O_SP + (size_t)NB * CB, O_CS = O_WP + (size_t)NB * 16 * 4096, O_GS = O_CS + (size_t)NSB * 3 * 3072,
    O_SS = O_GS + (size_t)NSB * 8 * 16384, O_WS = O_SS + (size_t)NSB * CB;
constexpr size_t al256(size_t x) { return (x + 255) & ~(size_t)255; }
constexpr size_t W_WIN = 0, W_WLORA = W_WIN + al256((size_t)NPAD * 1024 * 2), W_WOUT = W_WLORA + al256((size_t)3072 * 256 * 2), W_WFF1 = W_WOUT + al256((size_t)1024 * 1024 * 2),
    W_WFF2 = W_WFF1 + al256((size_t)4096 * 1024 * 2), W_XB = W_WFF2 + al256((size_t)LDF * 1024 * 2), W_P = W_XB + al256((size_t)(NSEG * MPR + 256) * 1024 * 2), W_QKV = W_P + al256((size_t)MP * NPAD * 2),
    W_BG = W_QKV + al256((size_t)MP * 3072 * 2), W_LA = W_BG + al256((size_t)MP * 16 * 4), W_L = W_LA + al256((size_t)MP * 256 * 2), W_T = W_L + al256((size_t)MP * 3072 * 2),
    W_GC = W_T + al256((size_t)NITEM * 8192 * 2), W_MG = W_GC + al256((size_t)NITEM * 64 * 4), W_PL = W_MG + al256((size_t)MP * 1024 * 2), W_CC = W_PL + al256((size_t)MP * 1024 * 4),
    W_SC = W_CC + al256((size_t)2 * NB * 3 * 3072 * 2), W_HB = W_SC + al256((size_t)2 * NB * CB * 2), W_BAR = W_HB + al256((size_t)MP * 1024 * 2), W_END = W_BAR + 16384;

struct Params { const float* in[29]; float* out; unsigned char* ws; int ph_lo, ph_hi; int rep_mask, pad0; };

__device__ __forceinline__ int ltid() { int t = threadIdx.x; asm volatile("" : "+v"(t)); return t; }
__device__ __forceinline__ float bf2f(unsigned v) { return __uint_as_float(v << 16); }
__device__ __forceinline__ float bflo(unsigned v) { return __uint_as_float(v << 16); }
__device__ __forceinline__ float bfhi(unsigned v) { return __uint_as_float(v & 0xffff0000u); }
__device__ __forceinline__ bf16_t f2bf(float f) { return (bf16_t)(cvt_pk_bf16(f, 0.f) & 0xffffu); }
__device__ __forceinline__ float sigm(float x) { return __builtin_amdgcn_rcpf(1.0f + __expf(-x)); }
__device__ __forceinline__ float tanh_fast(float x) { return 1.0f - 2.0f * __builtin_amdgcn_rcpf(1.0f + __expf(2.0f * x)); }
__device__ __forceinline__ float softplus_fast(float x) { return x > 20.f ? x : __logf(1.0f + __expf(x)); }
__device__ __forceinline__ float siluf(float x) { return x * sigm(x); }
__device__ __forceinline__ float softplusf(float x) { return x > 20.f ? x : log1pf(__expf(x)); }
template <int CTRL> __device__ __forceinline__ float dppmov(float v) { return __int_as_float(__builtin_amdgcn_update_dpp(0, __float_as_int(v), CTRL, 0xf, 0xf, true)); }
__device__ __forceinline__ float wave_sum(float v) {
    v += dppmov<0xB1>(v); v += dppmov<0x4E>(v); v += dppmov<0x141>(v); v += dppmov<0x140>(v);
    const int vi = __float_as_int(v);
    const float r0 = __int_as_float(__builtin_amdgcn_readlane(vi, 0)), r1 = __int_as_float(__builtin_amdgcn_readlane(vi, 16)), r2 = __int_as_float(__builtin_amdgcn_readlane(vi, 32)), r3 = __int_as_float(__builtin_amdgcn_readlane(vi, 48));
    return (r0 + r1) + (r2 + r3);
}
template <int N> struct IC { static constexpr int value = N; };
template <int N> __device__ __forceinline__ void wave_sumN(float (&v)[N]) {
#pragma unroll
    for (int q = 0; q < N; ++q) v[q] += dppmov<0xB1>(v[q]);
#pragma unroll
    for (int q = 0; q < N; ++q) v[q] += dppmov<0x4E>(v[q]);
#pragma unroll
    for (int q = 0; q < N; ++q) v[q] += dppmov<0x141>(v[q]);
#pragma unroll
    for (int q = 0; q < N; ++q) v[q] += dppmov<0x140>(v[q]);
    float r0[N], r1[N], r2[N], r3[N];
#pragma unroll
    for (int q = 0; q < N; ++q) { const int vi = __float_as_int(v[q]);
        r0[q] = __int_as_float(__builtin_amdgcn_readlane(vi, 0)); r1[q] = __int_as_float(__builtin_amdgcn_readlane(vi, 16)); r2[q] = __int_as_float(__builtin_amdgcn_readlane(vi, 32)); r3[q] = __int_as_float(__builtin_amdgcn_readlane(vi, 48)); }
#pragma unroll
    for (int q = 0; q < N; ++q) v[q] = (r0[q] + r1[q]) + (r2[q] + r3[q]);
}
__device__ __forceinline__ float reduce8(float v) { v += dppmov<0xB1>(v); v += dppmov<0x4E>(v); v += dppmov<0x141>(v); return v; }
__device__ __forceinline__ void lds_barrier() { asm volatile("s_waitcnt lgkmcnt(0)" ::: "memory"); __builtin_amdgcn_s_barrier(); asm volatile("" ::: "memory"); }
__device__ __forceinline__ f32x4 mfma16(bf16x8 a, bf16x8 b, f32x4 c) { return __builtin_amdgcn_mfma_f32_16x16x32_bf16(a, b, c, 0, 0, 0); }

__device__ __forceinline__ const float* xrow_ptr(const Params& p, int r, int s) {
    if (r < MPR) { const int b = r / TS, tt = r % TS; return p.in[0] + ((size_t)(b * SEQ + s * TS + tt)) * D; }
    if (s == 0 && r < MPR + NSAMP) return p.in[1] + (size_t)(r - MPR) * D;
    return nullptr;
}
__device__ __forceinline__ float* yrow_ptr(const Params& p, int r, int s) {
    if (r < MPR) { const int b = r / TS, tt = r % TS; return p.out + O_YP + ((size_t)(b * SEQ + s * TS + tt)) * D; }
    return p.out + O_YS + (size_t)(r - MPR) * D;
}

template <int ACT> struct EpiB16 {
    static constexpr bool PERM = true, AFTER_DRAIN = false;
    bf16_t* O; int ldc; int hm;
    __device__ __forceinline__ void operator()(const f32x4 (&acc)[2][2][4][2], const pg8::Unit& u, int wr, int wc, int fr, int fq) const {
        const int row0 = u.pm * 256 + wr * 64 + fr, col0 = u.pn * 256 + wc * 32 + 8 * fq;
        if (ACT == 0 && hm) {
#pragma unroll
            for (int ai = 0; ai < 2; ++ai)
#pragma unroll
                for (int m = 0; m < 4; ++m) { const int row = row0 + ai * 128 + m * 16;
                    size_t rbase_; int tlen, rr;
                    if (row < MPR) { rbase_ = 0; tlen = TS; rr = row; } else { rbase_ = (size_t)MPR * 3072; tlen = NSS; rr = row - MPR; }
                    const int bb = rr / tlen, t = rr % tlen;
#pragma unroll
                    for (int bj = 0; bj < 2; ++bj) { const int c8 = col0 + bj * 128, vec = c8 >> 10, head = (c8 & 1023) >> 6, ch = c8 & 63;
                        const size_t off = rbase_ + ((((size_t)(bb * 8 + (head >> 1)) * tlen + t) * 2 + (head & 1)) * 3 + vec) * 64 + ch;
                        const f32x4 v0 = acc[ai][bj][m][0], v1 = acc[ai][bj][m][1];
                        u32x4 w; w.x = cvt_pk_bf16(v0[0], v0[1]); w.y = cvt_pk_bf16(v0[2], v0[3]); w.z = cvt_pk_bf16(v1[0], v1[1]); w.w = cvt_pk_bf16(v1[2], v1[3]);
                        if (row < MPR + NSAMP) *(u32x4*)(O + off) = w; } }
            return;
        }
#pragma unroll
        for (int ai = 0; ai < 2; ++ai)
#pragma unroll
            for (int m = 0; m < 4; ++m) { bf16_t* rowp = O + (size_t)(row0 + ai * 128 + m * 16) * ldc + col0;
#pragma unroll
                for (int bj = 0; bj < 2; ++bj) { f32x4 v0 = acc[ai][bj][m][0], v1 = acc[ai][bj][m][1];
                    if (ACT == 1) {
#pragma unroll
                        for (int j = 0; j < 4; ++j) { const float a = fmaxf(v0[j], 0.f), b = fmaxf(v1[j], 0.f); v0[j] = a * a; v1[j] = b * b; } }
                    u32x4 w; w.x = cvt_pk_bf16(v0[0], v0[1]); w.y = cvt_pk_bf16(v0[2], v0[3]); w.z = cvt_pk_bf16(v1[0], v1[1]); w.w = cvt_pk_bf16(v1[2], v1[3]);
                    *(u32x4*)(rowp + bj * 128) = w; } }
    }
};
struct EpiAdd {
    static constexpr bool PERM = false, AFTER_DRAIN = false;
    float* C; const float* xp; const float* xs; int s; int mode;
    __device__ __forceinline__ void operator()(const f32x4 (&acc)[2][2][4][2], const pg8::Unit& u, int wr, int wc, int fr, int fq) const {
        const int row0 = u.pm * 256 + wr * 64 + fr, col0 = u.pn * 256 + wc * 32 + 4 * fq;
#pragma unroll
        for (int ai = 0; ai < 2; ++ai)
#pragma unroll
            for (int m = 0; m < 4; ++m) { const int row = row0 + ai * 128 + m * 16; float* rowp = C + (size_t)row * 1024 + col0;
                const float* bp;
                if (mode) bp = rowp;
                else { if (row < MPR) { const int b = row / TS, tt = row % TS; bp = xp + ((size_t)(b * SEQ + s * TS + tt)) * D + col0; }
                       else if (s == 0 && row < MPR + NSAMP) bp = xs + (size_t)(row - MPR) * D + col0; else bp = nullptr; }
#pragma unroll
                for (int bj = 0; bj < 2; ++bj)
#pragma unroll
                    for (int n = 0; n < 2; ++n) { f32x4 bs = (f32x4){0.f, 0.f, 0.f, 0.f}; if (bp) bs = *(const f32x4*)(bp + bj * 128 + n * 16);
                        *(f32x4*)(rowp + bj * 128 + n * 16) = acc[ai][bj][m][n] + DN_ALPHA * bs; }
                asm volatile("" ::: "memory"); }
    }
};
__device__ __forceinline__ size_t xb_row0(int s);
__device__ __forceinline__ void ph_wprep(const Params& p, lds_t L) {
    LAS float* tile = (LAS float*)L;
    const int tid = ltid();
    bf16_t* xb = (bf16_t*)(p.ws + W_XB);
    const int cc = (tid & 127) * 8, G = gridDim.x, nr4 = (NSEG * MPR + 256) / 4;
    for (int i = 0; ; ++i) {
        const int it = blockIdx.x + i * G, cbase = blockIdx.x + i * 4 * G;
        const bool hasW = it < 4736, hasC = cbase < nr4;
        if (!hasW && !hasC) break;
        f32x4 ca[4], cb[4];
        if (hasC) {
#pragma unroll
            for (int u = 0; u < 4; ++u) { const int r4 = cbase + u * G; ca[u] = (f32x4){0.f, 0.f, 0.f, 0.f}; cb[u] = ca[u];
                if (r4 < nr4) { const int ra = r4 * 4 + (tid >> 7); const float* src;
                    if (ra < MP) src = xrow_ptr(p, ra, 0); else { const int q = ra - MP; src = xrow_ptr(p, q % MPR, 1 + q / MPR); }
                    if (src) { ca[u] = *(const f32x4*)(src + cc); cb[u] = *(const f32x4*)(src + cc + 4); } } }
        }
        if (hasW) {
            const float* W; bf16_t* WT; int K, N, NP_; int r = it; int ldw = 0;
            if (r < 2432) { W = p.in[6]; WT = (bf16_t*)(p.ws + W_WIN); K = 1024; N = COLS; NP_ = NPAD; }
            else if ((r -= 2432) < 256) { W = p.in[22]; WT = (bf16_t*)(p.ws + W_WOUT); K = 1024; N = 1024; NP_ = 1024; }
            else if ((r -= 256) < 1024) { W = p.in[25]; WT = (bf16_t*)(p.ws + W_WFF1); K = 1024; N = 4096; NP_ = 4096; }
            else { r -= 1024; W = p.in[26]; WT = (bf16_t*)(p.ws + W_WFF2); K = 4096; N = 1024; NP_ = 1024; ldw = LDF; }
            if (ldw == 0) ldw = K;
            const int ntl = NP_ / 64, k0 = (r / ntl) * 64, n0 = (r % ntl) * 64;
            { const int j = tid & 63, i0 = tid >> 6;
#pragma unroll
              for (int q = 0; q < 8; ++q) { const int ii = i0 + 8 * q; tile[ii * 65 + j] = (n0 + j < N) ? W[(size_t)(k0 + ii) * N + n0 + j] : 0.f; } }
            __syncthreads();
            { const int k2 = (tid & 31) * 2, nn = tid >> 5;
#pragma unroll
              for (int q = 0; q < 4; ++q) { const int n = nn + 16 * q; *(unsigned*)(WT + (size_t)(n0 + n) * ldw + k0 + k2) = cvt_pk_bf16(tile[k2 * 65 + n], tile[(k2 + 1) * 65 + n]); } }
            __syncthreads();
        }
        if (hasC) {
#pragma unroll
            for (int u = 0; u < 4; ++u) { const int r4 = cbase + u * G;
                if (r4 < nr4) { u32x4 o; o.x = cvt_pk_bf16(ca[u][0], ca[u][1]); o.y = cvt_pk_bf16(ca[u][2], ca[u][3]); o.z = cvt_pk_bf16(cb[u][0], cb[u][1]); o.w = cvt_pk_bf16(cb[u][2], cb[u][3]);
                    *(u32x4*)(xb + (size_t)(r4 * 4 + (tid >> 7)) * 1024 + cc) = o; } }
        }
    }
    bf16_t* WL = (bf16_t*)(p.ws + W_WLORA);
    for (int idx = blockIdx.x * 512 + tid; idx < 3072 * 256; idx += gridDim.x * 512) {
        const int n = idx >> 8, k = idx & 255; float v = 0.f;
        if (n < 1024) { if (k < 64) v = p.in[13][k * 1024 + n]; }
        else if (n < 2048) { if (k >= 64 && k < 128) v = p.in[15][(k - 64) * 1024 + n - 1024]; }
        else { if (k >= 128) v = p.in[16][(k - 128) * 1024 + n - 2048]; }
        WL[idx] = f2bf(v);
    }
}
__device__ __forceinline__ size_t xb_row0(int s) { return (size_t)s * MPR + (s > 0 ? 256 : 0); }
__device__ __forceinline__ void ph_cvt_all(const Params& p) {
    bf16_t* xb = (bf16_t*)(p.ws + W_XB);
    const int tid = ltid();
    const int c = (tid & 127) * 8, G = gridDim.x, nr4 = (NSEG * MPR + 256) / 4;
    for (int base = blockIdx.x; base < nr4; base += 4 * G) {
        f32x4 a[4], b[4];
#pragma unroll
        for (int u = 0; u < 4; ++u) { const int r4 = base + u * G; a[u] = (f32x4){0.f, 0.f, 0.f, 0.f}; b[u] = a[u];
            if (r4 < nr4) { const int ra = r4 * 4 + (tid >> 7); const float* src;
                if (ra < MP) src = xrow_ptr(p, ra, 0); else { const int q = ra - MP; src = xrow_ptr(p, q % MPR, 1 + q / MPR); }
                if (src) { a[u] = *(const f32x4*)(src + c); b[u] = *(const f32x4*)(src + c + 4); } } }
#pragma unroll
        for (int u = 0; u < 4; ++u) { const int r4 = base + u * G;
            if (r4 < nr4) { u32x4 o; o.x = cvt_pk_bf16(a[u][0], a[u][1]); o.y = cvt_pk_bf16(a[u][2], a[u][3]); o.z = cvt_pk_bf16(b[u][0], b[u][1]); o.w = cvt_pk_bf16(b[u][2], b[u][3]);
                *(u32x4*)(xb + (size_t)(r4 * 4 + (tid >> 7)) * 1024 + c) = o; } }
    }
}
__device__ __forceinline__ void ph_prep(const Params& p, int s) {
    const bf16_t* P = (const bf16_t*)(p.ws + W_P);
    bf16_t* QKV = (bf16_t*)(p.ws + W_QKV); float* BG = (float*)(p.ws + W_BG); bf16_t* LA = (bf16_t*)(p.ws + W_LA);
    bf16_t* CC = (bf16_t*)(p.ws + W_CC); bf16_t* SC = (bf16_t*)(p.ws + W_SC);
    const int tid = ltid();
    constexpr int GR = 16;
    const int ngr = ((s == 0) ? (MPR + NSAMP) : MPR) / GR;
    const float* cw = p.in[7];
    for (int g = blockIdx.x; g < ngr; g += gridDim.x) {
        const int r0 = g * GR; const bool samp = r0 >= MPR;
        const int b = samp ? (r0 - MPR) / NSS : r0 / TS, tt0 = samp ? (r0 - MPR) % NSS : r0 % TS, tlen = samp ? NSS : TS;
        const bool lastg = (tt0 == tlen - GR);
        unsigned raw[3][GR + 3]; float xf0[3][3], xf1[3][3];
        const int cmode = (tt0 > 0) ? 0 : (samp ? 1 : (s > 0 ? 2 : 3));
#pragma unroll
        for (int sec = 0; sec < 3; ++sec) { const int ch = sec * 1024 + 2 * tid;
#pragma unroll
            for (int q = 0; q < GR + 3; ++q) {
                if (q >= 3 || cmode == 0) raw[sec][q] = *(const unsigned*)(P + (size_t)(r0 - 3 + q) * NPAD + ch);
                else if (cmode == 2) raw[sec][q] = *(const unsigned*)(CC + ((size_t)((s & 1) * NB + b) * 3 + q) * 3072 + ch);
                else raw[sec][q] = 0u;
                if (q < 3) { xf0[sec][q] = 0.f; xf1[sec][q] = 0.f; if (cmode == 1) { const float* sp = p.in[2] + ((size_t)(b * 3 + q)) * 3072 + ch; xf0[sec][q] = sp[0]; xf1[sec][q] = sp[1]; } }
            } }
        float lpv[GR / 2], lprev[GR / 2];
#pragma unroll
        for (int e = 0; e < GR / 2; ++e) { const int item = tid + 512 * e, j = item >> 8, c = item & 255, col = 3072 + c;
            lpv[e] = bf2f(P[(size_t)(r0 + j) * NPAD + C_PB + col]);
            if (tt0 + j > 0) lprev[e] = bf2f(P[(size_t)(r0 + j - 1) * NPAD + C_PB + col]);
            else if (samp) lprev[e] = p.in[4][(size_t)b * CB + col];
            else if (s > 0) lprev[e] = bf2f(SC[((size_t)((s & 1) * NB + b)) * CB + col]);
            else lprev[e] = 0.f; }
#pragma unroll
        for (int sec = 0; sec < 3; ++sec) {
            const int ch = sec * 1024 + 2 * tid;
            float x0[GR + 3], x1[GR + 3];
#pragma unroll
            for (int q = 0; q < GR + 3; ++q) { x0[q] = bflo(raw[sec][q]); x1[q] = bfhi(raw[sec][q]); if (q < 3 && cmode == 1) { x0[q] = xf0[sec][q]; x1[q] = xf1[sec][q]; } }
            float w0[4], w1[4];
#pragma unroll
            for (int j = 0; j < 4; ++j) { w0[j] = cw[j * 3072 + ch]; w1[j] = cw[j * 3072 + ch + 1]; }
#pragma unroll
            for (int j = 0; j < GR; ++j) {
                float y0 = 0.f, y1 = 0.f;
#pragma unroll
                for (int t = 0; t < 4; ++t) { y0 += w0[t] * x0[j + t]; y1 += w1[t] * x1[j + t]; }
                y0 = siluf(y0); y1 = siluf(y1);
                if (sec < 2) { const float ss = wave_sum(y0 * y0 + y1 * y1); float rn = rsqrtf(ss + 1e-6f); if (sec == 0) rn *= 0.08838834764831845f; y0 *= rn; y1 *= rn; }
                *(unsigned*)(QKV + (size_t)(r0 + j) * 3072 + ch) = cvt_pk_bf16(y0, y1);
            }
            if (lastg) {
#pragma unroll
                for (int j = GR - 3; j < GR; ++j) { const int ci = j - (GR - 3);
                    if (!samp) { *(unsigned*)(CC + ((size_t)(((s + 1) & 1) * NB + b) * 3 + ci) * 3072 + ch) = raw[sec][j + 3];
                        if (s == NSEG - 1) { float* o = p.out + O_CP + ((size_t)(b * 3 + ci)) * 3072 + ch; o[0] = x0[j + 3]; o[1] = x1[j + 3]; } }
                    else { float* o = p.out + O_CS + ((size_t)(b * 3 + ci)) * 3072 + ch; o[0] = x0[j + 3]; o[1] = x1[j + 3]; }
                }
            }
        }
        if (tid < GR * 8) { const int j = tid >> 3, h = tid & 7; const bf16_t* Pr = P + (size_t)(r0 + j) * NPAD;
            const float br = bf2f(Pr[C_BETA + h]), ar = bf2f(Pr[C_AR + h]);
            BG[(size_t)(r0 + j) * 16 + h] = sigm(br); BG[(size_t)(r0 + j) * 16 + 8 + h] = -__expf(p.in[8][h]) * softplusf(ar + p.in[9][h]); }
#pragma unroll
        for (int e = 0; e < GR / 2; ++e) { const int item = tid + 512 * e, j = item >> 8, c = item & 255, col = 3072 + c;
            const float pv = lpv[e], prev = lprev[e];
            const float xs = pv + p.in[11][col] * (prev - pv);
            const float v = (c < 64) ? tanh_fast(xs) : ((c < 128) ? xs : sigm(xs));
            LA[(size_t)(r0 + j) * 256 + c] = f2bf(v); }
        if (lastg) { const bf16_t* Pr = P + (size_t)(r0 + GR - 1) * NPAD + C_PB;
            for (int c = tid; c < CB; c += 512) { const bf16_t v = Pr[c];
                if (!samp) { SC[((size_t)(((s + 1) & 1) * NB + b)) * CB + c] = v; if (s == NSEG - 1) p.out[O_SP + (size_t)b * CB + c] = bf2f(v); }
                else p.out[O_SS + (size_t)b * CB + c] = bf2f(v); } }
    }
}
template <int WHICH> __device__ __forceinline__ void ph_ln(const Params& p, int s) {
    float* PL = (float*)(p.ws + W_PL); bf16_t* hb = (bf16_t*)(p.ws + W_HB);
    const int tidl = ltid(); const int lane = tidl & 63, wave = tidl >> 6, nv = (s == 0) ? (MPR + NSAMP) : MPR;
    const float* gg = p.in[WHICH == 0 ? 23 : 27]; const float* bb = p.in[WHICH == 0 ? 24 : 28];
    f32x4 gv[4], bv[4];
#pragma unroll
    for (int j = 0; j < 4; ++j) { gv[j] = *(const f32x4*)(gg + (lane + 64 * j) * 4); bv[j] = *(const f32x4*)(bb + (lane + 64 * j) * 4); }
    const int stride = gridDim.x * 8;
    int r = blockIdx.x * 8 + wave;
    f32x4 v[4];
    if (r < nv) {
#pragma unroll
        for (int j = 0; j < 4; ++j) v[j] = *(const f32x4*)(PL + (size_t)r * 1024 + (lane + 64 * j) * 4); }
    for (; r < nv; r += stride) {
        float* xr = PL + (size_t)r * 1024;
        f32x4 vn[4];
#pragma unroll
        for (int j = 0; j < 4; ++j) vn[j] = v[j];
        if (r + stride < nv) {
#pragma unroll
            for (int j = 0; j < 4; ++j) vn[j] = *(const f32x4*)(PL + (size_t)(r + stride) * 1024 + (lane + 64 * j) * 4); }
        float sm = 0.f;
#pragma unroll
        for (int j = 0; j < 4; ++j) sm += (v[j][0] + v[j][1]) + (v[j][2] + v[j][3]);
        const float mean = wave_sum(sm) * (1.f / 1024.f); float s2 = 0.f;
#pragma unroll
        for (int j = 0; j < 4; ++j) { v[j] = v[j] - mean; s2 += (v[j][0] * v[j][0] + v[j][1] * v[j][1]) + (v[j][2] * v[j][2] + v[j][3] * v[j][3]); }
        const float rstd = rsqrtf(wave_sum(s2) * (1.f / 1024.f) + 1e-5f);
        float* yo = (WHICH == 0) ? xr : yrow_ptr(p, r, s);
#pragma unroll
        for (int j = 0; j < 4; ++j) { const f32x4 o = v[j] * rstd * gv[j] + bv[j]; *(f32x4*)(yo + (lane + 64 * j) * 4) = o;
            if (WHICH == 0) { u32x2 w; w.x = cvt_pk_bf16(o[0], o[1]); w.y = cvt_pk_bf16(o[2], o[3]); *(u32x2*)(hb + (size_t)r * 1024 + (lane + 64 * j) * 4) = w; } }
#pragma unroll
        for (int j = 0; j < 4; ++j) v[j] = vn[j];
    }
}
__device__ __forceinline__ void ph_gdnpre(const Params& p, lds_t L, int s) {
    const bf16_t* QKV = (const bf16_t*)(p.ws + W_QKV); const float* BG = (const float*)(p.ws + W_BG);
    bf16_t* Tm = (bf16_t*)(p.ws + W_T); float* GC = (float*)(p.ws + W_GC);
    const int tidl = ltid(); const int lane = tidl & 63, wave = tidl >> 6, l15 = lane & 15, lq = lane >> 4;
    LAS float* Af = (LAS float*)(L + wave * 16896); LAS float* gcs = Af + 4096; LAS float* bts = gcs + 64;
    const int ni = (s == 0) ? NITEM : NITEM_P;
    for (int it = blockIdx.x * 8 + wave; it < ni; it += gridDim.x * 8) {
        int row0, h, nvalid;
        if (it < NITEM_P) { const int b = it >> 6, ck = (it >> 3) & 7; h = it & 7; row0 = b * TS + ck * 64; nvalid = 64; }
        else { const int j = it - NITEM_P; h = j & 7; row0 = MPR + (j >> 3) * NSS; nvalid = NSS; }
        float g = 0.f, bt = 0.f;
        if (lane < nvalid) { g = BG[(size_t)(row0 + lane) * 16 + 8 + h]; bt = BG[(size_t)(row0 + lane) * 16 + h]; }
#pragma unroll
        for (int o = 1; o < 64; o <<= 1) { const float t = __shfl_up(g, o); if (lane >= o) g += t; }
        gcs[lane] = g; bts[lane] = bt;
        f32x4 acc[4][4];
#pragma unroll
        for (int I = 0; I < 4; ++I)
#pragma unroll
            for (int J = 0; J < 4; ++J) acc[I][J] = (f32x4){0.f, 0.f, 0.f, 0.f};
#pragma unroll
        for (int kk = 0; kk < 4; ++kk) {
            bf16x8 fr[4];
#pragma unroll
            for (int I = 0; I < 4; ++I) { const int row = 16 * I + l15; u32x4 v = (u32x4){0u, 0u, 0u, 0u};
                if (row < nvalid) v = *(const u32x4*)(QKV + (size_t)(row0 + row) * 3072 + 1024 + h * 128 + kk * 32 + 8 * lq);
                fr[I] = __builtin_bit_cast(bf16x8, v); }
#pragma unroll
            for (int I = 0; I < 4; ++I)
#pragma unroll
                for (int J = 0; J <= I; ++J) acc[I][J] = mfma16(fr[I], fr[J], acc[I][J]);
            asm volatile("" ::: "memory");
        }
        asm volatile("s_waitcnt lgkmcnt(0)" ::: "memory");
#pragma unroll
        for (int I = 0; I < 4; ++I)
#pragma unroll
            for (int J = 0; J < 4; ++J)
#pragma unroll
                for (int jj = 0; jj < 4; ++jj) { const int i = 16 * I + 4 * lq + jj, j = 16 * J + l15;
                    float val = 0.f; if (J <= I && i > j) val = bts[i] * acc[I][J][jj] * __expf(gcs[i] - gcs[j]);
                    Af[i * 64 + j] = val; }
        asm volatile("s_waitcnt lgkmcnt(0)" ::: "memory");
        float t[64];
        int ll = lane; asm volatile("" : "+v"(ll));
#pragma unroll
        for (int i = 0; i < 64; ++i) {
            float a0 = (ll == i) ? 1.f : 0.f, a1 = 0.f;
#pragma unroll
            for (int j4 = 0; j4 < i; j4 += 4) { const f32x4 av = *(const LAS f32x4*)(Af + i * 64 + j4);
                a0 -= av[0] * t[j4]; if (j4 + 1 < i) a1 -= av[1] * t[j4 + 1]; if (j4 + 2 < i) a0 -= av[2] * t[j4 + 2]; if (j4 + 3 < i) a1 -= av[3] * t[j4 + 3]; }
            t[i] = a0 + a1;
            asm volatile("" ::: "memory");
        }
        const float sb = bts[lane], sg = sb * __expf(gcs[lane]);
        const float gcl = gcs[lane];
        asm volatile("s_waitcnt lgkmcnt(0)" ::: "memory");
        LAS bf16_t* TL = (LAS bf16_t*)Af;
#pragma unroll
        for (int i = 0; i < 64; ++i) { TL[i * 64 + lane] = f2bf(t[i] * sb); TL[4096 + i * 64 + lane] = f2bf(t[i] * sg); if ((i & 3) == 3) asm volatile("" ::: "memory"); }
        asm volatile("s_waitcnt lgkmcnt(0)" ::: "memory");
        bf16_t* Tb = Tm + (size_t)it * 8192;
#pragma unroll
        for (int q = 0; q < 16; ++q) *(u32x4*)(Tb + (size_t)(lane + 64 * q) * 8) = *(const LAS u32x4*)(TL + (lane + 64 * q) * 8);
        GC[(size_t)it * 64 + lane] = gcl;
        asm volatile("s_waitcnt lgkmcnt(0)" ::: "memory");
    }
}

constexpr int G_QH = 0, G_KH = 17408, G_KT = 34816, G_VT = 53248, G_VS = 71680, G_TB = 90112, G_TG = 99328, G_QK = 108544, G_SB = 117760, G_SM = 152576;
__device__ __forceinline__ int tofs(int r, int c) { return (r * 72 + c) * 2; }
#define LFRAG(off) (*(const LAS bf16x8*)(L + (off)))
__device__ __forceinline__ void gdn_seq(const Params& p, lds_t L, int row0, int nchunks, int nvalid, int item0, int h, const float* Sin, float* Sout) {
    const bf16_t* P = (const bf16_t*)(p.ws + W_P); const bf16_t* QKV = (const bf16_t*)(p.ws + W_QKV);
    const bf16_t* Tm = (const bf16_t*)(p.ws + W_T); const float* GC = (const float*)(p.ws + W_GC); bf16_t* MG = (bf16_t*)(p.ws + W_MG);
    const int tid = ltid(), lane = tid & 63, wave = tid >> 6, l15 = lane & 15, lq = lane >> 4;
    LAS float* SM = (LAS float*)(L + G_SM);
    f32x4 accS[8];
#pragma unroll
    for (int kt = 0; kt < 8; ++kt) { accS[kt] = (f32x4){0.f, 0.f, 0.f, 0.f}; if (Sin) accS[kt] = *(const f32x4*)(Sin + (size_t)(16 * kt + l15) * 128 + 16 * wave + 4 * lq); }
    const float ng0 = p.in[10][2 * lane], ng1 = p.in[10][2 * lane + 1];
    u32x4 pq[2], pk[2], pv[2], ptb, ptg; float pgc, pgl;
    auto gload = [&](int c) {
        const int r0n = row0 + c * 64, itn = item0 + c * 8;
        int tl2 = tid; asm volatile("" : "+v"(tl2));
        const int ln = tl2 & 63, wv = tl2 >> 6;
#pragma unroll
        for (int e = 0; e < 2; ++e) { const int c8 = (wv * 2 + e) * 8;
            pq[e] = (u32x4){0u, 0u, 0u, 0u}; pk[e] = pq[e]; pv[e] = pq[e];
            if (ln < nvalid) { const bf16_t* src = QKV + (size_t)(r0n + ln) * 3072 + h * 128 + c8; pq[e] = *(const u32x4*)src; pk[e] = *(const u32x4*)(src + 1024); pv[e] = *(const u32x4*)(src + 2048); } }
        { const int row = tl2 >> 3, c8 = (tl2 & 7) * 8; const bf16_t* src = Tm + (size_t)itn * 8192 + row * 64 + c8; ptb = *(const u32x4*)src; ptg = *(const u32x4*)(src + 4096); }
        pgc = GC[(size_t)itn * 64 + ln]; pgl = GC[(size_t)itn * 64 + 63];
    };
    gload(0);
    for (int ck = 0; ck < nchunks; ++ck) {
        const int r0 = row0 + ck * 64, item = item0 + ck * 8;
        int tl_ = tid; asm volatile("" : "+v"(tl_));
        const int lane = tl_ & 63, wave = tl_ >> 6, l15 = lane & 15, lq = lane >> 4;
#pragma unroll
        for (int e = 0; e < 2; ++e) {
            const int row = lane, c8 = (wave * 2 + e) * 8;
            const u32x4 q = pq[e], k = pk[e], v = pv[e];
            *(LAS u32x4*)(L + G_QH + (row * 136 + c8) * 2) = q;
            *(LAS u32x4*)(L + G_KH + (row * 136 + c8) * 2) = k;
#pragma unroll
            for (int x = 0; x < 4; ++x) {
                *(LAS bf16_t*)(L + G_KT + tofs(c8 + 2 * x, row)) = (bf16_t)(k[x] & 0xffffu); *(LAS bf16_t*)(L + G_KT + tofs(c8 + 2 * x + 1, row)) = (bf16_t)(k[x] >> 16);
                *(LAS bf16_t*)(L + G_VT + tofs(c8 + 2 * x, row)) = (bf16_t)(v[x] & 0xffffu); *(LAS bf16_t*)(L + G_VT + tofs(c8 + 2 * x + 1, row)) = (bf16_t)(v[x] >> 16);
            }
        }
        { const int row = tid >> 3, c8 = (tid & 7) * 8;
          *(LAS u32x4*)(L + G_TB + (row * 72 + c8) * 2) = ptb; *(LAS u32x4*)(L + G_TG + (row * 72 + c8) * 2) = ptg; }
        if (tid < 64) { const float gcv = pgc, gl = pgl;
            SM[tid] = gcv; SM[64 + tid] = __expf(gcv); SM[128 + tid] = __expf(gl - gcv); if (tid == 0) SM[192] = __expf(gl); }
        if (ck + 1 < nchunks) gload(ck + 1);
        if (ck == 0) {
#pragma unroll
            for (int kt = 0; kt < 8; ++kt)
#pragma unroll
                for (int jj = 0; jj < 4; ++jj) *(LAS bf16_t*)(L + G_SB + ((16 * wave + 4 * lq + jj) * 136 + 16 * kt + l15) * 2) = f2bf(accS[kt][jj]);
        }
        lds_barrier();
        {
            const int tI = wave >> 1;
#pragma unroll
            for (int x = 0; x < 2; ++x) { const int tJ = 2 * (wave & 1) + x; f32x4 a = (f32x4){0.f, 0.f, 0.f, 0.f};
                if (tJ <= tI) {
#pragma unroll
                    for (int kk = 0; kk < 4; ++kk) a = mfma16(LFRAG(G_QH + ((16 * tI + l15) * 136 + kk * 32 + 8 * lq) * 2), LFRAG(G_KH + ((16 * tJ + l15) * 136 + kk * 32 + 8 * lq) * 2), a); }
#pragma unroll
                for (int jj = 0; jj < 4; ++jj) { const int i = 16 * tI + 4 * lq + jj, j = 16 * tJ + l15;
                    const float val = (i >= j) ? a[jj] * __expf(SM[i] - SM[j]) : 0.f;
                    *(LAS bf16_t*)(L + G_QK + (i * 72 + j) * 2) = f2bf(val); } }
        }
        f32x4 accU[4], accW[4];
#pragma unroll
        for (int ct = 0; ct < 4; ++ct) { accU[ct] = (f32x4){0.f, 0.f, 0.f, 0.f}; accW[ct] = accU[ct];
#pragma unroll
            for (int js = 0; js < 2; ++js) {
                accU[ct] = mfma16(LFRAG(G_VT + tofs(16 * wave + l15, js * 32 + 8 * lq)), LFRAG(G_TB + ((16 * ct + l15) * 72 + js * 32 + 8 * lq) * 2), accU[ct]);
                accW[ct] = mfma16(LFRAG(G_TG + ((16 * ct + l15) * 72 + js * 32 + 8 * lq) * 2), LFRAG(G_KT + tofs(16 * wave + l15, js * 32 + 8 * lq)), accW[ct]); }
            asm volatile("" ::: "memory"); }
        lds_barrier();
#pragma unroll
        for (int ct = 0; ct < 4; ++ct)
#pragma unroll
            for (int jj = 0; jj < 4; ++jj) *(LAS bf16_t*)(L + G_KH + ((16 * ct + 4 * lq + jj) * 136 + 16 * wave + l15) * 2) = f2bf(-accW[ct][jj]);
        lds_barrier();
        unsigned zz8[8], ga8[8];
#pragma unroll
        for (int q = 0; q < 8; ++q) { const int c = wave + 8 * q; zz8[q] = 0u; ga8[q] = 0u;
            if (c < nvalid) { const size_t row = (size_t)(r0 + c); const int col = h * 128 + 2 * lane; zz8[q] = *(const unsigned*)(P + row * NPAD + C_Z + col); ga8[q] = *(const unsigned*)(P + row * NPAD + C_GA + col); } }
        f32x4 accO[4];
        {
            bf16x8 sf[4];
#pragma unroll
            for (int ks = 0; ks < 4; ++ks) sf[ks] = LFRAG(G_SB + ((16 * wave + l15) * 136 + ks * 32 + 8 * lq) * 2);
#pragma unroll
            for (int ct = 0; ct < 4; ++ct) { accO[ct] = (f32x4){0.f, 0.f, 0.f, 0.f};
#pragma unroll
                for (int ks = 0; ks < 4; ++ks) {
                    accU[ct] = mfma16(sf[ks], LFRAG(G_KH + ((16 * ct + l15) * 136 + ks * 32 + 8 * lq) * 2), accU[ct]);
                    accO[ct] = mfma16(sf[ks], LFRAG(G_QH + ((16 * ct + l15) * 136 + ks * 32 + 8 * lq) * 2), accO[ct]); }
                const int c = 16 * ct + l15; const float ec = SM[128 + c], eg = SM[64 + c];
#pragma unroll
                for (int jj = 0; jj < 4; ++jj) { const int v = 16 * wave + 4 * lq + jj;
                    *(LAS bf16_t*)(L + G_VT + tofs(v, c)) = f2bf(accU[ct][jj]); *(LAS bf16_t*)(L + G_VS + tofs(v, c)) = f2bf(accU[ct][jj] * ec);
                    accO[ct][jj] *= eg; }
                asm volatile("" ::: "memory"); }
        }
        lds_barrier();
        {
            bf16x8 vf[2], vsf[2];
#pragma unroll
            for (int js = 0; js < 2; ++js) { vf[js] = LFRAG(G_VT + tofs(16 * wave + l15, js * 32 + 8 * lq)); vsf[js] = LFRAG(G_VS + tofs(16 * wave + l15, js * 32 + 8 * lq)); }
#pragma unroll
            for (int ct = 0; ct < 4; ++ct) {
#pragma unroll
                for (int js = 0; js < 2; ++js) accO[ct] = mfma16(vf[js], LFRAG(G_QK + ((16 * ct + l15) * 72 + js * 32 + 8 * lq) * 2), accO[ct]);
                *(LAS f32x4*)(L + ((16 * ct + l15) * 132 + 16 * wave + 4 * lq) * 4) = accO[ct];
                asm volatile("" ::: "memory"); }
            const float egl = SM[192];
#pragma unroll
            for (int kt = 0; kt < 8; ++kt) { accS[kt] = accS[kt] * egl;
#pragma unroll
                for (int js = 0; js < 2; ++js) accS[kt] = mfma16(vsf[js], LFRAG(G_KT + tofs(16 * kt + l15, js * 32 + 8 * lq)), accS[kt]);
#pragma unroll
                for (int jj = 0; jj < 4; ++jj) *(LAS bf16_t*)(L + G_SB + ((16 * wave + 4 * lq + jj) * 136 + 16 * kt + l15) * 2) = f2bf(accS[kt][jj]);
                asm volatile("" ::: "memory"); }
        }
        lds_barrier();
#pragma unroll
        for (int q = 0; q < 8; ++q) { const int c = wave + 8 * q;
            if (c < nvalid) {
                const f32x2 o = *(const LAS f32x2*)(L + (c * 132 + 2 * lane) * 4);
                const float ss = wave_sum(o[0] * o[0] + o[1] * o[1]); const float rinv = rsqrtf(ss * (1.f / 128.f) + 1e-6f);
                const size_t row = (size_t)(r0 + c); const int col = h * 128 + 2 * lane;
                const unsigned zz = zz8[q], ga = ga8[q];
                const float o0 = o[0] * rinv * ng0 * siluf(bflo(zz)) * sigm(bflo(ga)), o1 = o[1] * rinv * ng1 * siluf(bfhi(zz)) * sigm(bfhi(ga));
                *(unsigned*)(MG + row * 1024 + col) = cvt_pk_bf16(o0, o1); } }
        lds_barrier();
    }
    { int so = l15 * 128 + 16 * wave + 4 * lq; asm volatile("" : "+v"(so));
#pragma unroll
      for (int kt = 0; kt < 8; ++kt) *(f32x4*)(Sout + (size_t)(so + kt * 2048)) = accS[kt]; }
}
constexpr int R_OP = 57344, R_YB = 114688;
__device__ __forceinline__ void rwkv_seq(const Params& p, lds_t L, int s, int rbase, int T, bool samp, int b, int h, const float* Sin, float* Sout) {
    const bf16_t* P = (const bf16_t*)(p.ws + W_P); const bf16_t* LR = (const bf16_t*)(p.ws + W_L); bf16_t* MG = (bf16_t*)(p.ws + W_MG);
    const bf16_t* SC = (const bf16_t*)(p.ws + W_SC);
    const int tid = ltid(), lane = tid & 63, wave = tid >> 6;
    const int NT = (T + 15) / 16;
    const bool scanner = wave < 4;
    typedef float f32x16 __attribute__((ext_vector_type(16)));
    const int hh_s = wave >> 1, half = wave & 1, cl = lane & 31, hf = lane >> 5;
    f32x16 T0, T1;
    const int hh_l = wave & 1, st0 = (wave < 4) ? 2 * (wave >> 1) : 4 + 6 * ((wave - 4) >> 1);
    const int hg_s = 2 * h + hh_s;
    const int hg = 2 * h + hh_l;
    const int hc = hg * 64 + lane;
    const size_t lbase = samp ? ((size_t)MPR * 3072 + (size_t)((b * 8 + h) * NSS) * 384) : ((size_t)((b * 8 + h) * TS) * 384);
    float c_mur = 0.f, c_muk = 0.f, c_muv = 0.f, c_w0 = 0.f, c_a0 = 0.f, c_kk = 0.f, c_ka = 0.f, c_rk = 0.f, c_lg = 0.f, c_lb = 0.f, c_pr = 0.f, c_pk = 0.f, c_pv = 0.f;
    if (scanner) {
#pragma unroll
        for (int g = 0; g < 4; ++g) { f32x4 t0 = (f32x4){0.f, 0.f, 0.f, 0.f}, t1 = t0;
            if (Sin) { const float* sp = Sin + ((size_t)hg_s * 64 + 32 * half + cl) * 64 + 8 * g + 4 * hf; t0 = *(const f32x4*)sp; t1 = *(const f32x4*)(sp + 32); }
#pragma unroll
            for (int q = 0; q < 4; ++q) { T0[4 * g + q] = t0[q]; T1[4 * g + q] = t1[q]; } }
        float one = 1.0f; asm volatile("" : "+v"(one)); T0 *= one; T1 *= one;
    }
    {
        if (samp) { c_pr = p.in[4][(size_t)b * CB + hc]; c_pk = p.in[4][(size_t)b * CB + 1024 + hc]; c_pv = p.in[4][(size_t)b * CB + 2048 + hc]; }
        else if (s > 0) { const bf16_t* sc = SC + ((size_t)((s & 1) * NB + b)) * CB; c_pr = bf2f(sc[hc]); c_pk = bf2f(sc[1024 + hc]); c_pv = bf2f(sc[2048 + hc]); }
    }
    typedef unsigned short us2 __attribute__((ext_vector_type(2)));
    struct RawA { us2 rk[6], vl[6], ll[6], q0, q1; };
    struct RawB { us2 go[6]; };
    auto issueA = [&](auto nqc, int nl, RawA& a) {
        constexpr int NQ = decltype(nqc)::value;
        const int tb = nl * 16 + st0;
#pragma unroll
        for (int q = 0; q < NQ; ++q) { const size_t row = (size_t)(rbase + tb + q); const bf16_t* Pr = P + row * NPAD + C_PB; const bf16_t* Lr = LR + lbase + (size_t)((tb + q) * 2 + hh_l) * 192 + lane;
            a.rk[q].x = Pr[hc]; a.rk[q].y = Pr[1024 + hc]; a.vl[q].x = Pr[2048 + hc]; a.vl[q].y = Lr[0]; a.ll[q].x = Lr[64]; a.ll[q].y = Lr[128]; }
        if (tb > 0) { const bf16_t* Pq = P + (size_t)(rbase + tb - 1) * NPAD + C_PB; a.q0.x = Pq[hc]; a.q0.y = Pq[1024 + hc]; a.q1.x = Pq[2048 + hc]; a.q1.y = 0; }
        else { a.q0.x = 0; a.q0.y = 0; a.q1.x = 0; a.q1.y = 1; }
    };
    auto issueB = [&](auto nqc, int np, RawB& bq) {
        constexpr int NQ = decltype(nqc)::value;
        const int tb = np * 16 + st0;
#pragma unroll
        for (int q = 0; q < NQ; ++q) { const size_t row = (size_t)(rbase + tb + q); bq.go[q].x = P[row * NPAD + C_GB + hc]; bq.go[q].y = MG[row * 1024 + hc]; }
    };
    auto postcalc = [&](auto nqc, int np, float (&outv)[6]) {
        constexpr int NQ = decltype(nqc)::value;
        int hl = hc; asm volatile("" : "+v"(hl));
        const float c_rk = p.in[19][hl], c_lg = p.in[20][hl], c_lb = p.in[21][hl];
        const LAS float* OP = (const LAS float*)(L + (np & 1) * R_OP); const LAS float* YB = (const LAS float*)(L + R_YB + (np & 1) * 8192);
        float y[NQ], m[NQ], bs[NQ], vq[NQ], gq[NQ];
#pragma unroll
        for (int q = 0; q < NQ; ++q) { const int tt = st0 + q; const LAS float* o = OP + ((hh_l * 16 + tt) * 7) * 64 + lane;
            y[q] = YB[(hh_l * 16 + tt) * 64 + lane]; m[q] = y[q]; bs[q] = o[256] * o[192] * c_rk; vq[q] = o[320]; gq[q] = o[384]; }
        wave_sumN<NQ>(m); wave_sumN<NQ>(bs);
        float d[NQ], var[NQ];
#pragma unroll
        for (int q = 0; q < NQ; ++q) { d[q] = y[q] - m[q] * (1.f / 64.f); var[q] = d[q] * d[q]; }
        wave_sumN<NQ>(var);
#pragma unroll
        for (int q = 0; q < NQ; ++q) { const float yn = d[q] * rsqrtf(var[q] * (1.f / 64.f) + 64e-5f) * c_lg + c_lb; outv[q] = (yn + bs[q] * vq[q]) * gq[q]; }
    };
    auto postwrite = [&](auto nqc, int np, const RawB& bq, const float (&outv)[6]) {
        constexpr int NQ = decltype(nqc)::value;
        const int tb = np * 16 + st0;
        float eg[NQ];
#pragma unroll
        for (int q = 0; q < NQ; ++q) eg[q] = __expf(-bf2f(bq.go[q].x));
#pragma unroll
        for (int q = 0; q < NQ; ++q) eg[q] = __builtin_amdgcn_rcpf(1.0f + eg[q]);
#pragma unroll
        for (int q = 0; q < NQ; ++q) { const size_t row = (size_t)(rbase + tb + q); MG[row * 1024 + hc] = f2bf(bf2f(bq.go[q].y) + eg[q] * outv[q]); }
    };
    auto transform = [&](auto nqc, int nl, const RawA& a) {
        constexpr int NQ = decltype(nqc)::value;
        LAS float* OP = (LAS float*)(L + (nl & 1) * R_OP);
        int hl = hc; asm volatile("" : "+v"(hl));
        const float c_mur = p.in[11][hl], c_muk = p.in[11][1024 + hl], c_muv = p.in[11][2048 + hl], c_w0 = p.in[12][hl], c_a0 = p.in[14][hl], c_kk = p.in[17][hl], c_ka = p.in[18][hl];
        float qr = c_pr, qk = c_pk, qv = c_pv;
        if (a.q1.y == 0) { qr = bf2f(a.q0.x); qk = bf2f(a.q0.y); qv = bf2f(a.q1.x); }
        float xr[NQ], xk[NQ], xv[NQ], kkv[NQ], ss[NQ], e1[NQ], e2[NQ];
#pragma unroll
        for (int q = 0; q < NQ; ++q) { const float pr = bf2f(a.rk[q].x), pk = bf2f(a.rk[q].y), pv = bf2f(a.vl[q].x);
            xr[q] = pr + c_mur * (qr - pr); xk[q] = pk + c_muk * (qk - pk); xv[q] = pv + c_muv * (qv - pv); qr = pr; qk = pk; qv = pv;
            kkv[q] = xk[q] * c_kk; ss[q] = kkv[q] * kkv[q]; }
        wave_sumN<NQ>(ss);
#pragma unroll
        for (int q = 0; q < NQ; ++q) { e1[q] = __expf(-(c_w0 + bf2f(a.vl[q].y))); e2[q] = __expf(-(c_a0 + bf2f(a.ll[q].x))); }
        float sw[NQ], asig[NQ], rn[NQ];
#pragma unroll
        for (int q = 0; q < NQ; ++q) { sw[q] = __builtin_amdgcn_rcpf(1.0f + e1[q]); asig[q] = __builtin_amdgcn_rcpf(1.0f + e2[q]); rn[q] = rsqrtf(ss[q] + 1e-6f); }
        float dec[NQ];
#pragma unroll
        for (int q = 0; q < NQ; ++q) dec[q] = __expf(-0.6065306597126334f * sw[q]);
#pragma unroll
        for (int q = 0; q < NQ; ++q) { const int tt = st0 + q; const float kk = kkv[q] * rn[q]; const float kmod = xk[q] * (1.f + (asig[q] - 1.f) * c_ka);
            LAS float* o = OP + ((hh_l * 16 + tt) * 7) * 64 + lane;
            o[0] = dec[q]; o[64] = -kk; o[128] = kk * asig[q]; o[192] = kmod; o[256] = xr[q]; o[320] = xv[q]; o[384] = bf2f(a.ll[q].y); }
    };
    auto scan_tile = [&](const LAS float* OP, LAS float* YB) {
        const int roff = 4 * hf;
        const int abase = (hf ? 192 : 128) + cl;
        for (int tt = 0; tt < 16; ++tt) {
            const LAS float* op = OP + ((hh_s * 16 + tt) * 7) * 64;
            f32x4 ar[2][4], wr[2][4];
#pragma unroll
            for (int jb = 0; jb < 2; ++jb)
#pragma unroll
                for (int g = 0; g < 4; ++g) { ar[jb][g] = *(const LAS f32x4*)(op + 64 + 32 * jb + 8 * g + roff); wr[jb][g] = *(const LAS f32x4*)(op + 32 * jb + 8 * g + roff); }
            const float aop0 = op[abase], aop1 = op[abase + 32], vv = op[320 + 32 * half + cl];
            f32x4 acc = (f32x4){0.f, 0.f, 0.f, 0.f}, acd = acc;
#pragma unroll
            for (int g = 0; g < 4; ++g) { const f32x4 t0 = (f32x4){T0[4 * g], T0[4 * g + 1], T0[4 * g + 2], T0[4 * g + 3]}, t1 = (f32x4){T1[4 * g], T1[4 * g + 1], T1[4 * g + 2], T1[4 * g + 3]};
                acc += t0 * ar[0][g]; acd += t1 * ar[1][g]; }
            acc += acd;
            const float part = (acc[0] + acc[1]) + (acc[2] + acc[3]);
            const float sa = part + __shfl_xor(part, 32);
            const float bop = hf ? vv : sa;
#pragma unroll
            for (int g = 0; g < 4; ++g)
#pragma unroll
                for (int q = 0; q < 4; ++q) { T0[4 * g + q] *= wr[0][g][q]; T1[4 * g + q] *= wr[1][g][q]; }
            T0 = __builtin_amdgcn_mfma_f32_32x32x2f32(aop0, bop, T0, 0, 0, 0);
            T1 = __builtin_amdgcn_mfma_f32_32x32x2f32(aop1, bop, T1, 0, 0, 0);
            f32x4 yc = (f32x4){0.f, 0.f, 0.f, 0.f}, yd = yc;
#pragma unroll
            for (int g = 0; g < 4; ++g) { const f32x4 r0 = *(const LAS f32x4*)(op + 256 + 8 * g + roff), r1 = *(const LAS f32x4*)(op + 256 + 32 + 8 * g + roff);
                const f32x4 t0 = (f32x4){T0[4 * g], T0[4 * g + 1], T0[4 * g + 2], T0[4 * g + 3]}, t1 = (f32x4){T1[4 * g], T1[4 * g + 1], T1[4 * g + 2], T1[4 * g + 3]};
                yc += t0 * r0; yd += t1 * r1; }
            yc += yd;
            const float yp = (yc[0] + yc[1]) + (yc[2] + yc[3]);
            const float y = yp + __shfl_xor(yp, 32);
            if (hf == 0) YB[(hh_s * 16 + tt) * 64 + 32 * half + cl] = y;
        }
    };
    auto work = [&](auto nqc, int n, RawA& Acur, RawA& Anext) {
        RawB Bq; float outv[6];
        if (scanner) { const LAS float* OP = (const LAS float*)(L + (n & 1) * R_OP); LAS float* YB = (LAS float*)(L + R_YB + (n & 1) * 8192); scan_tile(OP, YB); }
        if (n >= 1) issueB(nqc, n - 1, Bq);
        if (n + 2 < NT) issueA(nqc, n + 2, Anext);
        if (n >= 1) postcalc(nqc, n - 1, outv);
        if (n + 1 < NT) transform(nqc, n + 1, Acur);
        if (n >= 1) postwrite(nqc, n - 1, Bq, outv);
    };
    auto iter = [&](int n, RawA& Acur, RawA& Anext) {
        if (scanner) work(IC<2>{}, n, Acur, Anext); else work(IC<6>{}, n, Acur, Anext);
        lds_barrier();
    };
    RawA A0, A1;
    if (scanner) { issueA(IC<2>{}, 0, A1); transform(IC<2>{}, 0, A1); if (NT > 1) issueA(IC<2>{}, 1, A0); }
    else { issueA(IC<6>{}, 0, A1); transform(IC<6>{}, 0, A1); if (NT > 1) issueA(IC<6>{}, 1, A0); }
    __syncthreads();
    for (int n = 0; n < NT; n += 2) {
        iter(n, A0, A1);
        if (n + 1 < NT) iter(n + 1, A1, A0);
    }
    { RawB Bq; float outv[6];
      if (scanner) { issueB(IC<2>{}, NT - 1, Bq); postcalc(IC<2>{}, NT - 1, outv); postwrite(IC<2>{}, NT - 1, Bq, outv); }
      else { issueB(IC<6>{}, NT - 1, Bq); postcalc(IC<6>{}, NT - 1, outv); postwrite(IC<6>{}, NT - 1, Bq, outv); } }
    if (scanner) {
#pragma unroll
        for (int g = 0; g < 4; ++g) { float* sp = Sout + ((size_t)hg_s * 64 + 32 * half + cl) * 64 + 8 * g + 4 * hf;
            *(f32x4*)sp = (f32x4){T0[4 * g], T0[4 * g + 1], T0[4 * g + 2], T0[4 * g + 3]}; *(f32x4*)(sp + 32) = (f32x4){T1[4 * g], T1[4 * g + 1], T1[4 * g + 2], T1[4 * g + 3]}; }
    }
    __syncthreads();
}

__device__ __forceinline__ void ph_seq(const Params& p, lds_t L, int s) {
    for (int blk = blockIdx.x; blk < NB * 8; blk += gridDim.x) {
        const int b = blk >> 3, h = blk & 7;
        float* gst = p.out + O_GP + ((size_t)(b * 8 + h)) * 16384;
#ifndef NO_GDN
        gdn_seq(p, L, b * TS, TS / 64, 64, (b << 6) + h, h, s > 0 ? gst : nullptr, gst);
#endif
        float* wst = p.out + O_WP + (size_t)b * 16 * 4096;
#ifndef NO_RWKV
        rwkv_seq(p, L, s, b * TS, TS, false, b, h, s > 0 ? wst : nullptr, wst);
#endif
    }
#ifndef NO_SAMP
    if (s == 0) for (int blk = blockIdx.x; blk < NSB * 8; blk += gridDim.x) {
        const int sb = blk >> 3, h = blk & 7;
        gdn_seq(p, L, MPR + sb * NSS, 1, NSS, NITEM_P + blk, h, p.in[3] + ((size_t)(sb * 8 + h)) * 16384, p.out + O_GS + ((size_t)(sb * 8 + h)) * 16384);
        rwkv_seq(p, L, s, MPR + sb * NSS, NSS, true, sb, h, p.in[5] + (size_t)sb * 16 * 4096, p.out + O_WS + (size_t)sb * 16 * 4096);
    }
#endif
}

#ifdef ONLY
#define EN(x) ((x) == ONLY)
#elif defined(ENMASK)
#define EN(x) (((ENMASK) >> ((x) == 100 ? 11 : (x))) & 1)
#else
#define EN(x) true
#endif

template <int MODE> __device__ __forceinline__ void skinny_gemm(const Params& p, lds_t L, const bf16_t* A, int lda, const bf16_t* Bt, int ldb, int N, int K) {
    const int tid = ltid(), lane = tid & 63, wave = tid >> 6, l15 = lane & 15, lq = lane >> 4;
    LAS float* red = (LAS float*)L;
    const int ntile = 8 * (N / 16), kw = K / 8;
    float* PL = (float*)(p.ws + W_PL); bf16_t* Fb = (bf16_t*)(p.ws + W_P);
    for (int t = blockIdx.x; t < ntile; t += gridDim.x) {
        const int tr = t & 7, tc = t >> 3;
        const bf16_t* ap = A + (size_t)(16 * tr + l15) * lda + wave * kw + 8 * lq;
        const bf16_t* bp = Bt + (size_t)(16 * tc + l15) * ldb + wave * kw + 8 * lq;
        f32x4 acc = (f32x4){0.f, 0.f, 0.f, 0.f};
        for (int k0 = 0; k0 < kw; k0 += 128) {
            u32x4 af[4], bf[4];
#pragma unroll
            for (int u = 0; u < 4; ++u) { af[u] = *(const u32x4*)(ap + k0 + 32 * u); bf[u] = *(const u32x4*)(bp + k0 + 32 * u); }
#pragma unroll
            for (int u = 0; u < 4; ++u) acc = mfma16(__builtin_bit_cast(bf16x8, af[u]), __builtin_bit_cast(bf16x8, bf[u]), acc);
        }
#pragma unroll
        for (int jj = 0; jj < 4; ++jj) red[wave * 256 + (4 * lq + jj) * 16 + l15] = acc[jj];
        __syncthreads();
        if (tid < 256) {
            float v = 0.f;
#pragma unroll
            for (int w = 0; w < 8; ++w) v += red[w * 256 + tid];
            const int r = 16 * tr + (tid >> 4), c = 16 * tc + (tid & 15); const size_t row = (size_t)(MPR + r);
            if (MODE == 0) PL[row * 1024 + c] = v + DN_ALPHA * p.in[1][(size_t)r * D + c];
            else if (MODE == 1) { const float a = fmaxf(v, 0.f); Fb[row * LDF + c] = f2bf(a * a); }
            else PL[row * 1024 + c] = v + DN_ALPHA * PL[row * 1024 + c];
        }
        __syncthreads();
    }
}
#define XB_TMO      128
#define XB_XCNT(j)  (256  + 64 * (j))
#define XB_XSUB(j)  (1280 + 64 * (j))
#define XB_XGEN(j)  (2304 + 64 * (j))
#define XB_TOP      3328
#define XB_TOPGEN   3392
#define XCD_BAR_WORDS 3456
#define XB_SPIN_CAP (1u << 20)
__device__ __forceinline__ unsigned xb_ld(unsigned* p)              { return __hip_atomic_load(p, __ATOMIC_RELAXED, __HIP_MEMORY_SCOPE_AGENT); }
__device__ __forceinline__ unsigned xb_add(unsigned* p, unsigned v) { return __hip_atomic_fetch_add(p, v, __ATOMIC_RELAXED, __HIP_MEMORY_SCOPE_AGENT); }
__device__ __forceinline__ unsigned xb_xcc_id() { return (unsigned)__builtin_amdgcn_s_getreg((3 << 11) | 20) & 0xFu; }
#define XB_SPIN(cond, bar) do { unsigned _sp = 0; while (cond) { __builtin_amdgcn_s_sleep(1); \
    if ((++_sp & 255u) == 0u) { if (xb_ld(&(bar)[XB_TMO])) break; if (_sp > XB_SPIN_CAP) { atomicAdd(&(bar)[XB_TMO], 1u); break; } } } } while (0)
struct XcdBarrier { unsigned* bar; unsigned x; volatile LAS unsigned* st; };
__device__ __forceinline__ XcdBarrier xcd_barrier_post(unsigned* bar, volatile LAS unsigned* st) {
    XcdBarrier b; b.bar = bar; b.x = xb_xcc_id(); b.st = st;
    if (threadIdx.x == 0) (void)xb_add(&bar[XB_XCNT(b.x)], 1u);
    return b;
}
__device__ __forceinline__ void xcd_barrier_complete(unsigned* bar, unsigned x, unsigned& nloc, unsigned& nx) {
    const unsigned G = gridDim.x * gridDim.y * gridDim.z;
    unsigned sum, cnt, mine, sp = 0u;
    for (;;) {
        sum = 0u; cnt = 0u; mine = 0u;
#pragma unroll
        for (unsigned j = 0; j < 16; ++j) { const unsigned c = xb_ld(&bar[XB_XCNT(j)]); sum += c; cnt += (c > 0u) ? 1u : 0u; mine = (j == x) ? c : mine; }
        if (sum == G) break;
        __builtin_amdgcn_s_sleep(1);
        if ((++sp & 255u) == 0u) { if (xb_ld(&bar[XB_TMO])) break; if (sp > XB_SPIN_CAP) { atomicAdd(&bar[XB_TMO], 1u); break; } }
    }
    nloc = mine > 0u ? mine : 1u; nx = cnt > 0u ? cnt : 1u;
}
__device__ __forceinline__ void xcd_barrier(const XcdBarrier& b) {
    asm volatile("s_waitcnt vmcnt(0)" ::: "memory");
    __syncthreads();
    if (threadIdx.x == 0) {
        unsigned* bar = b.bar;
        __builtin_amdgcn_s_waitcnt(0);
        unsigned nloc = b.st[0], nx = b.st[1];
        if (nloc == 0u) { xcd_barrier_complete(bar, b.x, nloc, nx); b.st[0] = nloc; b.st[1] = nx; }
        const unsigned old = xb_add(&bar[XB_XSUB(b.x)], 1u);
        const unsigned gen = old / nloc;
        if (old + 1u == (gen + 1u) * nloc) {
            __builtin_amdgcn_fence(__ATOMIC_RELEASE, "agent");
            asm volatile("s_waitcnt vmcnt(0)" ::: "memory");
            const unsigned og = xb_add(&bar[XB_TOP], 1u);
            const unsigned tg = og / nx;
            if (og + 1u == (tg + 1u) * nx) xb_add(&bar[XB_TOPGEN], 1u);
            else XB_SPIN(xb_ld(&bar[XB_TOPGEN]) == tg, bar);
            __builtin_amdgcn_fence(__ATOMIC_ACQUIRE, "agent");
            xb_add(&bar[XB_XGEN(b.x)], 1u);
            asm volatile("s_waitcnt vmcnt(0)" ::: "memory");
        } else {
            XB_SPIN(xb_ld(&bar[XB_XGEN(b.x)]) == gen, bar);
            __builtin_amdgcn_fence(__ATOMIC_ACQUIRE, "agent");
            asm volatile("s_waitcnt vmcnt(0)" ::: "memory");
        }
    }
    __syncthreads();
}
constexpr int PPS = 8;
constexpr int NPHASE = 1 + NSEG * PPS + 1;
__global__ __launch_bounds__(512, 2) void mega(Params p) {
    extern __shared__ __attribute__((aligned(16))) unsigned char shm[];
    lds_t L = (lds_t)shm;
    cg::grid_group grid = cg::this_grid();
    volatile LAS unsigned* st = (volatile LAS unsigned*)(L + (LDS_BYTES - 16));
    if (threadIdx.x == 0) { st[0] = 0u; st[1] = 0u; }
    __syncthreads();
    const XcdBarrier xb = xcd_barrier_post((unsigned*)(p.ws + W_BAR), st);
    int redone = 0;
    for (int ph = p.ph_lo; ph < p.ph_hi; ++ph) {
        if (ph == 0) ph_wprep(p, L);
        else if (ph == NPHASE - 1) ph_ln<1>(p, NSEG - 1);
        else {
            const int s = (ph - 1) / PPS, k = (ph - 1) % PPS;
            const int mps = (s == 0) ? MP : MPR;
            if (k == 0 || k == 2) {
                if (k == 0 && s > 0) ph_ln<1>(p, s - 1);
                pg8::Gemm g; EpiB16<0> E;
                if (k == 0) { g.A = (const bf16_t*)(p.ws + W_XB) + xb_row0(s) * 1024; g.Bt = (const bf16_t*)(p.ws + W_WIN); g.M = mps; g.N = NPAD; g.K = 1024; g.lda = 1024; g.ldb = 1024; E.O = (bf16_t*)(p.ws + W_P); E.ldc = NPAD; E.hm = 0; }
                else { g.A = (const bf16_t*)(p.ws + W_LA); g.Bt = (const bf16_t*)(p.ws + W_WLORA); g.M = mps; g.N = 3072; g.K = 256; g.lda = 256; g.ldb = 256; E.O = (bf16_t*)(p.ws + W_L); E.ldc = 3072; E.hm = 1; }
                pg8::StaticOrder S; S.init(g.M, g.N, (int)gridDim.x, (int)blockIdx.x);
                pg8::gemm_phase<EpiB16<0>, pg8::StaticOrder, false>(L, g, S, E, nullptr);
                if (k == 2) { __syncthreads(); ph_gdnpre(p, L, s); }
            }
            else if (k == 1) ph_prep(p, s);
            else if (k == 3) ph_seq(p, L, s);
            else if (k == 4 || k == 7) {
                pg8::Gemm g; EpiAdd E; E.C = (float*)(p.ws + W_PL); E.xp = p.in[0]; E.xs = p.in[1]; E.s = s;
                if (k == 4) { g.A = (const bf16_t*)(p.ws + W_MG); g.Bt = (const bf16_t*)(p.ws + W_WOUT); g.M = MPR; g.N = 1024; g.K = 1024; g.lda = 1024; g.ldb = 1024; E.mode = 0; }
                else { g.A = (const bf16_t*)(p.ws + W_P); g.Bt = (const bf16_t*)(p.ws + W_WFF2); g.M = MPR; g.N = 1024; g.K = 4096; g.lda = LDF; g.ldb = LDF; E.mode = 1; }
                pg8::StaticOrder S; S.init(g.M, g.N, (int)gridDim.x, (int)blockIdx.x);
                pg8::gemm_phase<EpiAdd, pg8::StaticOrder, false>(L, g, S, E, nullptr);
                if (s == 0) { __syncthreads();
                    if (k == 4) skinny_gemm<0>(p, L, (const bf16_t*)(p.ws + W_MG) + (size_t)MPR * 1024, 1024, (const bf16_t*)(p.ws + W_WOUT), 1024, 1024, 1024);
                    else skinny_gemm<2>(p, L, (const bf16_t*)(p.ws + W_P) + (size_t)MPR * LDF, LDF, (const bf16_t*)(p.ws + W_WFF2), LDF, 1024, 4096); }
            }
            else if (k == 5) ph_ln<0>(p, s);
            else {
                pg8::Gemm g; EpiB16<1> E; g.A = (const bf16_t*)(p.ws + W_HB); g.Bt = (const bf16_t*)(p.ws + W_WFF1); g.M = MPR; g.N = 4096; g.K = 1024; g.lda = 1024; g.ldb = 1024; E.O = (bf16_t*)(p.ws + W_P); E.ldc = LDF; E.hm = 0;
                pg8::StaticOrder S; S.init(g.M, g.N, (int)gridDim.x, (int)blockIdx.x);
                pg8::gemm_phase<EpiB16<1>, pg8::StaticOrder, false>(L, g, S, E, nullptr);
                if (s == 0) { __syncthreads(); skinny_gemm<1>(p, L, (const bf16_t*)(p.ws + W_HB) + (size_t)MPR * 1024, 1024, (const bf16_t*)(p.ws + W_WFF1), 1024, 4096, 1024); }
            }
        }
        if (ph + 1 < p.ph_hi) { if (p.rep_mask == 0x7fffffff) grid.sync();   xcd_barrier(xb); }
        if ((p.rep_mask & 0x100000) && ph >= 1 && ph < NPHASE - 1 && ((ph - 1) % PPS) == 2 && !((redone >> ((ph - 1) / PPS)) & 1)) { redone |= 1 << ((ph - 1) / PPS); ph -= 3; }
    }
}

#ifndef REP_MASK
#define REP_MASK 0
#endif
extern "C" void kernel_launch(void* const* d_in, const int* in_sizes, int n_in, void* d_out, int out_size, void* d_ws, size_t ws_size, hipStream_t stream) {
    static int grid = 0;
    if (grid == 0) {
        int dev = 0, cus = 0, per_cu = 0;
        hipGetDevice(&dev);
        hipDeviceGetAttribute(&cus, hipDeviceAttributeMultiprocessorCount, dev);
        if (hipFuncSetAttribute((const void*)mega, hipFuncAttributeMaxDynamicSharedMemorySize, LDS_BYTES) != hipSuccess) { fprintf(stderr, "hipFuncSetAttribute failed\n"); }
        if (hipOccupancyMaxActiveBlocksPerMultiprocessor(&per_cu, (const void*)mega, 512, LDS_BYTES) != hipSuccess || per_cu < 1) { fprintf(stderr, "occupancy query: %d\n", per_cu); per_cu = 1; }
        (void)hipGetLastError();
        grid = cus * 1;
        if (ws_size < W_END) { fprintf(stderr, "workspace too small: %zu < %zu\n", ws_size, (size_t)W_END); grid = -1; }
    }
    if (grid < 0) return;
    (void)hipMemsetAsync((unsigned char*)d_ws + W_BAR, 0, 16384, stream);
    Params p{};
    for (int i = 0; i < 29; ++i) p.in[i] = (const float*)d_in[i];
    p.out = (float*)d_out; p.ws = (unsigned char*)d_ws; p.rep_mask = REP_MASK;
#if defined(MK_MULTI)
    for (int ph = 0; ph < NPHASE; ++ph) { p.ph_lo = ph; p.ph_hi = ph + 1; hipLaunchKernelGGL(mega, dim3(grid), dim3(512), LDS_BYTES, stream, p); }
#else
    p.ph_lo = 0; p.ph_hi = NPHASE;
    void* args[] = {&p};
    hipError_t e = hipLaunchCooperativeKernel((const void*)mega, dim3(grid), dim3(512), args, LDS_BYTES, stream);
    if (e != hipSuccess) fprintf(stderr, "cooperative launch failed: %s (grid %d)\n", hipGetErrorString(e), grid);
#endif
}
```

```cpp
#include <hip/hip_runtime.h>
#include <hip/hip_cooperative_groups.h>
#include <cstdio>
namespace cg = cooperative_groups;
namespace pg8 {
#define PG8_LAS __attribute__((address_space(3)))
typedef unsigned short bf16_t;
typedef short bf16x8 __attribute__((ext_vector_type(8)));
typedef float f32x4 __attribute__((ext_vector_type(4)));
typedef unsigned u32x4 __attribute__((ext_vector_type(4)));
constexpr int BM = 256, BK = 64, HALF = 128, HTB = HALF * BK * 2  , STAGE_BYTES = 8 * HTB, NXCD = 8, WGM = 8;

__host__ __device__ __forceinline__ int lds_byte(int r, int c) { const int st = (r >> 4) * 2 + (c >> 5), rr = r & 15, cc = c & 31, ob = rr * 64 + cc * 2; return st * 1024 + (ob ^ (((ob >> 9) & 1) << 5)); }
__host__ __device__ __forceinline__ void stage_rc(int b, int& R, int& C) { const int st = b / 1024, sb = b % 1024, swz = sb ^ (((sb >> 9) & 1) << 5); R = (st >> 1) * 16 + swz / 64; C = (st & 1) * 32 + (swz % 64) / 2; }
__host__ __device__ __forceinline__ int perm32(int rho) { const int n = rho >> 4, i = rho & 15; return 8 * (i >> 2) + 4 * n + (i & 3); }

struct Unit { int pm, pn; };
struct Gemm { const bf16_t* A; const bf16_t* Bt; int M, N, K; int lda, ldb; };

struct StaticOrder {
    int nM, nN, nwg, G, c;
    __host__ __device__ void init(int M, int N, int G_, int c_) { nM = M / BM; nN = N / BM; nwg = nM * nN; G = G_; c = c_; }
    __host__ __device__ bool next(int i, Unit& u) const {
        const long L = (long)i * G + c; if (L >= nwg) return false;
        int wgid = (int)L; { const int q = nwg / NXCD, r = nwg % NXCD, xcd = wgid % NXCD, off = wgid / NXCD; wgid = (xcd < r ? xcd * (q + 1) : r * (q + 1) + (xcd - r) * q) + off; }
        const int nig = WGM * nN, gid = wgid / nig, fm = gid * WGM, gsz = (nM - fm) < WGM ? (nM - fm) : WGM;
        u.pm = fm + ((wgid % nig) % gsz); u.pn = (wgid % nig) / gsz; return true;
    }
    __device__ __forceinline__ void a_ready(const Unit&) const {}
    __device__ __forceinline__ void done(const Unit&) const {}
};
typedef float f32x2c __attribute__((ext_vector_type(2)));
typedef __bf16 bf16v2c __attribute__((ext_vector_type(2)));
__device__ __forceinline__ unsigned cvt_pk_bf16(float lo, float hi) { f32x2c f = {lo, hi}; bf16v2c v = __builtin_convertvector(f, bf16v2c); return __builtin_bit_cast(unsigned, v); }
template <class Epi, class Sched, bool STAMP = false>
__device__ __forceinline__ void gemm_phase(PG8_LAS unsigned char* lds, const Gemm g, const Sched& S, const Epi& E, unsigned long long* stamps) {
    int tid_l = threadIdx.x; asm volatile("" : "+v"(tid_l)); const int tid = tid_l, wid = __builtin_amdgcn_readfirstlane(tid >> 6), lane = tid & 63, wr = wid >> 2, wc = wid & 3, fr = lane & 15, fq = lane >> 4;
    const int K = g.K, nt = K / BK;
    int ts_lo = 0, ts_hi = 0, nts = 0; const unsigned long long rt_entry = STAMP ? (unsigned long long)wall_clock64() : 0ull;
#define PG8_STAMP() do { if (STAMP && wid == 0 && nts < 64) { const unsigned long long _c = (unsigned long long)clock64(); \
        ts_lo = (lane == nts) ? (int)(unsigned)_c : ts_lo; ts_hi = (lane == nts) ? (int)(unsigned)(_c >> 32) : ts_hi; ++nts; } } while (0)
    PG8_STAMP();
    unsigned voffA[2], voffB[2];
#pragma unroll
    for (int i = 0; i < 2; ++i) { int R, C; stage_rc(tid * 16 + i * 8192, R, C); const int Rb = Epi::PERM ? ((R & ~31) + perm32(R & 31)) : R;
        voffA[i] = (unsigned)(R * g.lda + C) * 2u; voffB[i] = (unsigned)(Rb * g.ldb + C) * 2u; }
    const size_t kstep = (size_t)(BK * 2);
    const size_t hstepA = (size_t)HALF * g.lda * 2, hstepB = (size_t)HALF * g.ldb * 2;
    const size_t tstepA = 2 * hstepA, tstepB = 2 * hstepB;
    const unsigned ldsw = (unsigned)wid * 1024u;
    const int aoff = lds_byte(wr * 64 + fr, fq * 8), boff = lds_byte(wc * 32 + fr, fq * 8);
#define PG8_SA(b, h) (((b) * 2 + (h)) * HTB)
#define PG8_SB(b, h) ((4 + (b) * 2 + (h)) * HTB)
#define PG8_STAGE(bufoff, gbase, voff) do { _Pragma("unroll") for (int _i = 0; _i < 2; ++_i) \
        __builtin_amdgcn_global_load_lds((const unsigned*)((const char*)(gbase) + (voff)[_i]), (PG8_LAS unsigned*)(lds + (bufoff) + ldsw + _i * 8192), 16, 0, 0); } while (0)
#define PG8_LDA(dst, b, h) do { _Pragma("unroll") for (int m = 0; m < 4; ++m) _Pragma("unroll") for (int k = 0; k < 2; ++k) dst[m][k] = *(const PG8_LAS bf16x8*)(lds + PG8_SA(b, h) + aoff + m * 2048 + k * 1024); } while (0)
#define PG8_LDB(dst, b, h) do { _Pragma("unroll") for (int n = 0; n < 2; ++n) _Pragma("unroll") for (int k = 0; k < 2; ++k) dst[n][k] = *(const PG8_LAS bf16x8*)(lds + PG8_SB(b, h) + boff + n * 2048 + k * 1024); } while (0)
#define PG8_MMA(ai, bj, At, Bt) do { __builtin_amdgcn_s_setprio(1); _Pragma("unroll") for (int m = 0; m < 4; ++m) _Pragma("unroll") for (int n = 0; n < 2; ++n) _Pragma("unroll") for (int k = 0; k < 2; ++k) \
        acc[ai][bj][m][n] = __builtin_amdgcn_mfma_f32_16x16x32_bf16(Bt[n][k], At[m][k], acc[ai][bj][m][n], 0, 0, 0); __builtin_amdgcn_s_setprio(0); } while (0)
#define PG8_WAIT_V(n) asm volatile("s_waitcnt vmcnt(" #n ")" ::: "memory")
#define PG8_WAIT_L(n) asm volatile("s_waitcnt lgkmcnt(" #n ")" ::: "memory")
#define PG8_BAR __builtin_amdgcn_s_barrier()
#define PG8_SCHED __builtin_amdgcn_sched_barrier(0)
    Unit cur, nxt; int ui = 0;
    if (!S.next(0, cur)) return;
    f32x4 acc[2][2][4][2];
#pragma unroll
    for (int a = 0; a < 2; ++a)
#pragma unroll
        for (int b = 0; b < 2; ++b)
#pragma unroll
            for (int m = 0; m < 4; ++m)
#pragma unroll
                for (int n = 0; n < 2; ++n) acc[a][b][m][n] = (f32x4){0.f, 0.f, 0.f, 0.f};
    bf16x8 At[4][2], B0[2][2], B1[2][2];
    const char* cA = (const char*)g.A + (size_t)cur.pm * tstepA; const char* cB = (const char*)g.Bt + (size_t)cur.pn * tstepB;
    S.a_ready(cur);
    PG8_STAGE(PG8_SB(0, 0), cB, voffB); PG8_STAGE(PG8_SA(0, 0), cA, voffA); PG8_STAGE(PG8_SB(0, 1), cB + hstepB, voffB); PG8_STAGE(PG8_SA(0, 1), cA + hstepA, voffA);
    if (wr == 1) PG8_BAR;
    PG8_WAIT_V(4); PG8_BAR;
    PG8_STAGE(PG8_SB(1, 0), cB + kstep, voffB); PG8_STAGE(PG8_SA(1, 0), cA + kstep, voffA); PG8_STAGE(PG8_SB(1, 1), cB + hstepB + kstep, voffB);
    PG8_WAIT_V(6); PG8_BAR;
    PG8_STAMP();
    for (;;) {
        const bool has_next = S.next(ui + 1, nxt);
        const char* nA = has_next ? (const char*)g.A + (size_t)nxt.pm * tstepA : cA; const char* nB = has_next ? (const char*)g.Bt + (size_t)nxt.pn * tstepB : cB;
        for (int t = 0; t < nt; t += 2) {
            const bool last = (t == nt - 2);
            const char* a1 = cA + (size_t)(t + 1) * kstep;
            const char* a2 = last ? nA : cA + (size_t)(t + 2) * kstep; const char* b2 = last ? nB : cB + (size_t)(t + 2) * kstep;
            const char* a3 = a2 + kstep; const char* b3 = b2 + kstep;
            if (last && has_next) S.a_ready(nxt);
            PG8_LDB(B0, 0, 0); PG8_SCHED; PG8_LDA(At, 0, 0); PG8_STAGE(PG8_SA(1, 1), a1 + hstepA, voffA);
            PG8_WAIT_L(8); PG8_BAR; PG8_WAIT_L(0); PG8_MMA(0, 0, At, B0); PG8_BAR; PG8_SCHED;
            PG8_LDB(B1, 0, 1); PG8_STAGE(PG8_SB(0, 0), b2, voffB);
            PG8_BAR; PG8_WAIT_L(0); PG8_MMA(0, 1, At, B1); PG8_BAR;
            PG8_LDA(At, 0, 1); PG8_STAGE(PG8_SA(0, 0), a2, voffA);
            PG8_BAR; PG8_WAIT_L(0); PG8_MMA(1, 0, At, B0); PG8_BAR; PG8_SCHED;
            PG8_STAGE(PG8_SB(0, 1), b2 + hstepB, voffB);
            PG8_WAIT_V(6); PG8_BAR; PG8_MMA(1, 1, At, B1); PG8_BAR;
            PG8_LDB(B0, 1, 0); PG8_SCHED; PG8_LDA(At, 1, 0); PG8_STAGE(PG8_SA(0, 1), a2 + hstepA, voffA);
            PG8_WAIT_L(8); PG8_BAR; PG8_WAIT_L(0); PG8_MMA(0, 0, At, B0); PG8_BAR; PG8_SCHED;
            PG8_LDB(B1, 1, 1); PG8_STAGE(PG8_SB(1, 0), b3, voffB);
            PG8_BAR; PG8_WAIT_L(0); PG8_MMA(0, 1, At, B1); PG8_BAR;
            PG8_LDA(At, 1, 1); PG8_STAGE(PG8_SA(1, 0), a3, voffA);
            PG8_BAR; PG8_WAIT_L(0); PG8_MMA(1, 0, At, B0); PG8_BAR; PG8_SCHED;
            PG8_STAGE(PG8_SB(1, 1), b3 + hstepB, voffB);
            PG8_WAIT_V(6); PG8_BAR; PG8_MMA(1, 1, At, B1); PG8_BAR;
        }
        PG8_STAMP();
        if constexpr (!Epi::AFTER_DRAIN) { E(acc, cur, wr, wc, fr, fq); S.done(cur); }
        PG8_STAMP();
        if (!has_next) break;
#pragma unroll
        for (int a = 0; a < 2; ++a)
#pragma unroll
            for (int b = 0; b < 2; ++b)
#pragma unroll
                for (int m = 0; m < 4; ++m)
#pragma unroll
                    for (int n = 0; n < 2; ++n) acc[a][b][m][n] = (f32x4){0.f, 0.f, 0.f, 0.f};
        cur = nxt; cA = nA; cB = nB; ++ui;
    }
    PG8_WAIT_V(0);
    if (wr == 0) PG8_BAR;
    PG8_BAR;
    if constexpr (Epi::AFTER_DRAIN) { E.fused(acc, cur, wr, wc, fr, fq, lds, wid, lane); S.done(cur); }
    PG8_STAMP();
    if (STAMP && wid == 0) { stamps[lane] = lane < nts ? (((unsigned long long)(unsigned)ts_hi << 32) | (unsigned)ts_lo) : 0ull;
        if (lane == 62) stamps[62] = rt_entry; if (lane == 63) stamps[63] = (unsigned long long)wall_clock64(); }
#undef PG8_STAMP
#undef PG8_SA
#undef PG8_SB
#undef PG8_STAGE
#undef PG8_LDA
#undef PG8_LDB
#undef PG8_MMA
#undef PG8_WAIT_V
#undef PG8_WAIT_L
#undef PG8_BAR
#undef PG8_SCHED
}
}
using pg8::bf16_t; using pg8::bf16x8; using pg8::f32x4; using pg8::u32x4; using pg8::cvt_pk_bf16;
typedef float f32x2 __attribute__((ext_vector_type(2)));
typedef unsigned u32x2 __attribute__((ext_vector_type(2)));
#define LAS __attribute__((address_space(3)))
typedef LAS unsigned char* lds_t;

constexpr int D = 1024, NB = 32, SEQ = 2048, NSB = 8, NSS = 16;
constexpr int TS = 512, NSEG = SEQ / TS;
constexpr int MPR = NB * TS;
constexpr int MP = MPR + 256;
constexpr int NSAMP = NSB * NSS;
constexpr int NPAD = 9728, COLS = 9488;
constexpr int C_Z = 3072, C_BETA = 4096, C_AR = 4104, C_PB = 4112, C_GA = 7440, C_GB = 8464, CB = 3328;
constexpr float DN_ALPHA = 1.189207115002721f;
constexpr int LDS_BYTES = 163840;
constexpr int LDF = 4096 + 64;
constexpr int NITEM_P = NB * (TS / 64) * 8;
constexpr int NITEM = NITEM_P + 64;

constexpr size_t O_YP = 0, O_YS = O_YP + (size_t)NB * SEQ * D, O_CP = O_YS + (size_t)NSAMP * D, O_GP = O_CP + (size_t)NB * 3 * 3072,
    O_SP = O_GP + (size_t)NB * 8 * 16384, O_WP = O_SP + (size_t)NB * CB, O_CS = O_WP + (size_t)NB * 16 * 4096, O_GS = O_CS + (size_t)NSB * 3 * 3072,
    O_SS = O_GS + (size_t)NSB * 8 * 16384, O_WS = O_SS + (size_t)NSB * CB;
constexpr size_t al256(size_t x) { return (x + 255) & ~(size_t)255; }
constexpr size_t W_WIN = 0, W_WLORA = W_WIN + al256((size_t)NPAD * 1024 * 2), W_WOUT = W_WLORA + al256((size_t)3072 * 256 * 2), W_WFF1 = W_WOUT + al256((size_t)1024 * 1024 * 2),
    W_WFF2 = W_WFF1 + al256((size_t)4096 * 1024 * 2), W_XB = W_WFF2 + al256((size_t)LDF * 1024 * 2), W_P = W_XB + al256((size_t)(NSEG * MPR + 256) * 1024 * 2), W_QKV = W_P + al256((size_t)MP * NPAD * 2),
    W_BG = W_QKV + al256((size_t)MP * 3072 * 2), W_LA = W_BG + al256((size_t)MP * 16 * 4), W_L = W_LA + al256((size_t)MP * 256 * 2), W_T = W_L + al256((size_t)MP * 3072 * 2),
    W_GC = W_T + al256((size_t)NITEM * 8192 * 2), W_MG = W_GC + al256((size_t)NITEM * 64 * 4), W_PL = W_MG + al256((size_t)MP * 1024 * 2), W_CC = W_PL + al256((size_t)MP * 1024 * 4),
    W_SC = W_CC + al256((size_t)2 * NB * 3 * 3072 * 2), W_HB = W_SC + al256((size_t)2 * NB * CB * 2), W_BAR = W_HB + al256((size_t)MP * 1024 * 2), W_END = W_BAR + 16384;

struct Params { const float* in[29]; float* out; unsigned char* ws; int ph_lo, ph_hi; int rep_mask, pad0; };

__device__ __forceinline__ int ltid() { int t = threadIdx.x; asm volatile("" : "+v"(t)); return t; }
__device__ __forceinline__ float bf2f(unsigned v) { return __uint_as_float(v << 16); }
__device__ __forceinline__ float bflo(unsigned v) { return __uint_as_float(v << 16); }
__device__ __forceinline__ float bfhi(unsigned v) { return __uint_as_float(v & 0xffff0000u); }
__device__ __forceinline__ bf16_t f2bf(float f) { return (bf16_t)(cvt_pk_bf16(f, 0.f) & 0xffffu); }
__device__ __forceinline__ float sigm(float x) { return __builtin_amdgcn_rcpf(1.0f + __expf(-x)); }
__device__ __forceinline__ float tanh_fast(float x) { return 1.0f - 2.0f * __builtin_amdgcn_rcpf(1.0f + __expf(2.0f * x)); }
__device__ __forceinline__ float softplus_fast(float x) { return x > 20.f ? x : __logf(1.0f + __expf(x)); }
__device__ __forceinline__ float siluf(float x) { return x * sigm(x); }
__device__ __forceinline__ float softplusf(float x) { return x > 20.f ? x : log1pf(__expf(x)); }
template <int CTRL> __device__ __forceinline__ float dppmov(float v) { return __int_as_float(__builtin_amdgcn_update_dpp(0, __float_as_int(v), CTRL, 0xf, 0xf, true)); }
__device__ __forceinline__ float wave_sum(float v) {
    v += dppmov<0xB1>(v); v += dppmov<0x4E>(v); v += dppmov<0x141>(v); v += dppmov<0x140>(v);
    const int vi = __float_as_int(v);
    const float r0 = __int_as_float(__builtin_amdgcn_readlane(vi, 0)), r1 = __int_as_float(__builtin_amdgcn_readlane(vi, 16)), r2 = __int_as_float(__builtin_amdgcn_readlane(vi, 32)), r3 = __int_as_float(__builtin_amdgcn_readlane(vi, 48));
    return (r0 + r1) + (r2 + r3);
}
template <int N> struct IC { static constexpr int value = N; };
template <int N> __device__ __forceinline__ void wave_sumN(float (&v)[N]) {
#pragma unroll
    for (int q = 0; q < N; ++q) v[q] += dppmov<0xB1>(v[q]);
#pragma unroll
    for (int q = 0; q < N; ++q) v[q] += dppmov<0x4E>(v[q]);
#pragma unroll
    for (int q = 0; q < N; ++q) v[q] += dppmov<0x141>(v[q]);
#pragma unroll
    for (int q = 0; q < N; ++q) v[q] += dppmov<0x140>(v[q]);
    float r0[N], r1[N], r2[N], r3[N];
#pragma unroll
    for (int q = 0; q < N; ++q) { const int vi = __float_as_int(v[q]);
        r0[q] = __int_as_float(__builtin_amdgcn_readlane(vi, 0)); r1[q] = __int_as_float(__builtin_amdgcn_readlane(vi, 16)); r2[q] = __int_as_float(__builtin_amdgcn_readlane(vi, 32)); r3[q] = __int_as_float(__builtin_amdgcn_readlane(vi, 48)); }
#pragma unroll
    for (int q = 0; q < N; ++q) v[q] = (r0[q] + r1[q]) + (r2[q] + r3[q]);
}
__device__ __forceinline__ float reduce8(float v) { v += dppmov<0xB1>(v); v += dppmov<0x4E>(v); v += dppmov<0x141>(v); return v; }
__device__ __forceinline__ void lds_barrier() { asm volatile("s_waitcnt lgkmcnt(0)" ::: "memory"); __builtin_amdgcn_s_barrier(); asm volatile("" ::: "memory"); }
__device__ __forceinline__ f32x4 mfma16(bf16x8 a, bf16x8 b, f32x4 c) { return __builtin_amdgcn_mfma_f32_16x16x32_bf16(a, b, c, 0, 0, 0); }

__device__ __forceinline__ const float* xrow_ptr(const Params& p, int r, int s) {
    if (r < MPR) { const int b = r / TS, tt = r % TS; return p.in[0] + ((size_t)(b * SEQ + s * TS + tt)) * D; }
    if (s == 0 && r < MPR + NSAMP) return p.in[1] + (size_t)(r - MPR) * D;
    return nullptr;
}
__device__ __forceinline__ float* yrow_ptr(const Params& p, int r, int s) {
    if (r < MPR) { const int b = r / TS, tt = r % TS; return p.out + O_YP + ((size_t)(b * SEQ + s * TS + tt)) * D; }
    return p.out + O_YS + (size_t)(r - MPR) * D;
}

template <int ACT> struct EpiB16 {
    static constexpr bool PERM = true, AFTER_DRAIN = false;
    bf16_t* O; int ldc; int hm;
    __device__ __forceinline__ void operator()(const f32x4 (&acc)[2][2][4][2], const pg8::Unit& u, int wr, int wc, int fr, int fq) const {
        const int row0 = u.pm * 256 + wr * 64 + fr, col0 = u.pn * 256 + wc * 32 + 8 * fq;
        if (ACT == 0 && hm) {
#pragma unroll
            for (int ai = 0; ai < 2; ++ai)
#pragma unroll
                for (int m = 0; m < 4; ++m) { const int row = row0 + ai * 128 + m * 16;
                    size_t rbase_; int tlen, rr;
                    if (row < MPR) { rbase_ = 0; tlen = TS; rr = row; } else { rbase_ = (size_t)MPR * 3072; tlen = NSS; rr = row - MPR; }
                    const int bb = rr / tlen, t = rr % tlen;
#pragma unroll
                    for (int bj = 0; bj < 2; ++bj) { const int c8 = col0 + bj * 128, vec = c8 >> 10, head = (c8 & 1023) >> 6, ch = c8 & 63;
                        const size_t off = rbase_ + ((((size_t)(bb * 8 + (head >> 1)) * tlen + t) * 2 + (head & 1)) * 3 + vec) * 64 + ch;
                        const f32x4 v0 = acc[ai][bj][m][0], v1 = acc[ai][bj][m][1];
                        u32x4 w; w.x = cvt_pk_bf16(v0[0], v0[1]); w.y = cvt_pk_bf16(v0[2], v0[3]); w.z = cvt_pk_bf16(v1[0], v1[1]); w.w = cvt_pk_bf16(v1[2], v1[3]);
                        if (row < MPR + NSAMP) *(u32x4*)(O + off) = w; } }
            return;
        }
#pragma unroll
        for (int ai = 0; ai < 2; ++ai)
#pragma unroll
            for (int m = 0; m < 4; ++m) { bf16_t* rowp = O + (size_t)(row0 + ai * 128 + m * 16) * ldc + col0;
#pragma unroll
                for (int bj = 0; bj < 2; ++bj) { f32x4 v0 = acc[ai][bj][m][0], v1 = acc[ai][bj][m][1];
                    if (ACT == 1) {
#pragma unroll
                        for (int j = 0; j < 4; ++j) { const float a = fmaxf(v0[j], 0.f), b = fmaxf(v1[j], 0.f); v0[j] = a * a; v1[j] = b * b; } }
                    u32x4 w; w.x = cvt_pk_bf16(v0[0], v0[1]); w.y = cvt_pk_bf16(v0[2], v0[3]); w.z = cvt_pk_bf16(v1[0], v1[1]); w.w = cvt_pk_bf16(v1[2], v1[3]);
                    *(u32x4*)(rowp + bj * 128) = w; } }
    }
};
struct EpiAdd {
    static constexpr bool PERM = false, AFTER_DRAIN = false;
    float* C; const float* xp; const float* xs; int s; int mode;
    __device__ __forceinline__ void operator()(const f32x4 (&acc)[2][2][4][2], const pg8::Unit& u, int wr, int wc, int fr, int fq) const {
        const int row0 = u.pm * 256 + wr * 64 + fr, col0 = u.pn * 256 + wc * 32 + 4 * fq;
#pragma unroll
        for (int ai = 0; ai < 2; ++ai)
#pragma unroll
            for (int m = 0; m < 4; ++m) { const int row = row0 + ai * 128 + m * 16; float* rowp = C + (size_t)row * 1024 + col0;
                const float* bp;
                if (mode) bp = rowp;
                else { if (row < MPR) { const int b = row / TS, tt = row % TS; bp = xp + ((size_t)(b * SEQ + s * TS + tt)) * D + col0; }
                       else if (s == 0 && row < MPR + NSAMP) bp = xs + (size_t)(row - MPR) * D + col0; else bp = nullptr; }
#pragma unroll
                for (int bj = 0; bj < 2; ++bj)
#pragma unroll
                    for (int n = 0; n < 2; ++n) { f32x4 bs = (f32x4){0.f, 0.f, 0.f, 0.f}; if (bp) bs = *(const f32x4*)(bp + bj * 128 + n * 16);
                        *(f32x4*)(rowp + bj * 128 + n * 16) = acc[ai][bj][m][n] + DN_ALPHA * bs; }
                asm volatile("" ::: "memory"); }
    }
};
__device__ __forceinline__ size_t xb_row0(int s);
__device__ __forceinline__ void ph_wprep(const Params& p, lds_t L) {
    LAS float* tile = (LAS float*)L;
    const int tid = ltid();
    bf16_t* xb = (bf16_t*)(p.ws + W_XB);
    const int cc = (tid & 127) * 8, G = gridDim.x, nr4 = (NSEG * MPR + 256) / 4;
    for (int i = 0; ; ++i) {
        const int it = blockIdx.x + i * G, cbase = blockIdx.x + i * 4 * G;
        const bool hasW = it < 4736, hasC = cbase < nr4;
        if (!hasW && !hasC) break;
        f32x4 ca[4], cb[4];
        if (hasC) {
#pragma unroll
            for (int u = 0; u < 4; ++u) { const int r4 = cbase + u * G; ca[u] = (f32x4){0.f, 0.f, 0.f, 0.f}; cb[u] = ca[u];
                if (r4 < nr4) { const int ra = r4 * 4 + (tid >> 7); const float* src;
                    if (ra < MP) src = xrow_ptr(p, ra, 0); else { const int q = ra - MP; src = xrow_ptr(p, q % MPR, 1 + q / MPR); }
                    if (src) { ca[u] = *(const f32x4*)(src + cc); cb[u] = *(const f32x4*)(src + cc + 4); } } }
        }
        if (hasW) {
            const float* W; bf16_t* WT; int K, N, NP_; int r = it; int ldw = 0;
            if (r < 2432) { W = p.in[6]; WT = (bf16_t*)(p.ws + W_WIN); K = 1024; N = COLS; NP_ = NPAD; }
            else if ((r -= 2432) < 256) { W = p.in[22]; WT = (bf16_t*)(p.ws + W_WOUT); K = 1024; N = 1024; NP_ = 1024; }
            else if ((r -= 256) < 1024) { W = p.in[25]; WT = (bf16_t*)(p.ws + W_WFF1); K = 1024; N = 4096; NP_ = 4096; }
            else { r -= 1024; W = p.in[26]; WT = (bf16_t*)(p.ws + W_WFF2); K = 4096; N = 1024; NP_ = 1024; ldw = LDF; }
            if (ldw == 0) ldw = K;
            const int ntl = NP_ / 64, k0 = (r / ntl) * 64, n0 = (r % ntl) * 64;
            { const int j = tid & 63, i0 = tid >> 6;
#pragma unroll
              for (int q = 0; q < 8; ++q) { const int ii = i0 + 8 * q; tile[ii * 65 + j] = (n0 + j < N) ? W[(size_t)(k0 + ii) * N + n0 + j] : 0.f; } }
            __syncthreads();
            { const int k2 = (tid & 31) * 2, nn = tid >> 5;
#pragma unroll
              for (int q = 0; q < 4; ++q) { const int n = nn + 16 * q; *(unsigned*)(WT + (size_t)(n0 + n) * ldw + k0 + k2) = cvt_pk_bf16(tile[k2 * 65 + n], tile[(k2 + 1) * 65 + n]); } }
            __syncthreads();
        }
        if (hasC) {
#pragma unroll
            for (int u = 0; u < 4; ++u) { const int r4 = cbase + u * G;
                if (r4 < nr4) { u32x4 o; o.x = cvt_pk_bf16(ca[u][0], ca[u][1]); o.y = cvt_pk_bf16(ca[u][2], ca[u][3]); o.z = cvt_pk_bf16(cb[u][0], cb[u][1]); o.w = cvt_pk_bf16(cb[u][2], cb[u][3]);
                    *(u32x4*)(xb + (size_t)(r4 * 4 + (tid >> 7)) * 1024 + cc) = o; } }
        }
    }
    bf16_t* WL = (bf16_t*)(p.ws + W_WLORA);
    for (int idx = blockIdx.x * 512 + tid; idx < 3072 * 256; idx += gridDim.x * 512) {
        const int n = idx >> 8, k = idx & 255; float v = 0.f;
        if (n < 1024) { if (k < 64) v = p.in[13][k * 1024 + n]; }
        else if (n < 2048) { if (k >= 64 && k < 128) v = p.in[15][(k - 64) * 1024 + n - 1024]; }
        else { if (k >= 128) v = p.in[16][(k - 128) * 1024 + n - 2048]; }
        WL[idx] = f2bf(v);
    }
}
__device__ __forceinline__ size_t xb_row0(int s) { return (size_t)s * MPR + (s > 0 ? 256 : 0); }
__device__ __forceinline__ void ph_cvt_all(const Params& p) {
    bf16_t* xb = (bf16_t*)(p.ws + W_XB);
    const int tid = ltid();
    const int c = (tid & 127) * 8, G = gridDim.x, nr4 = (NSEG * MPR + 256) / 4;
    for (int base = blockIdx.x; base < nr4; base += 4 * G) {
        f32x4 a[4], b[4];
#pragma unroll
        for (int u = 0; u < 4; ++u) { const int r4 = base + u * G; a[u] = (f32x4){0.f, 0.f, 0.f, 0.f}; b[u] = a[u];
            if (r4 < nr4) { const int ra = r4 * 4 + (tid >> 7); const float* src;
                if (ra < MP) src = xrow_ptr(p, ra, 0); else { const int q = ra - MP; src = xrow_ptr(p, q % MPR, 1 + q / MPR); }
                if (src) { a[u] = *(const f32x4*)(src + c); b[u] = *(const f32x4*)(src + c + 4); } } }
#pragma unroll
        for (int u = 0; u < 4; ++u) { const int r4 = base + u * G;
            if (r4 < nr4) { u32x4 o; o.x = cvt_pk_bf16(a[u][0], a[u][1]); o.y = cvt_pk_bf16(a[u][2], a[u][3]); o.z = cvt_pk_bf16(b[u][0], b[u][1]); o.w = cvt_pk_bf16(b[u][2], b[u][3]);
                *(u32x4*)(xb + (size_t)(r4 * 4 + (tid >> 7)) * 1024 + c) = o; } }
    }
}
__device__ __forceinline__ void ph_prep(const Params& p, int s) {
    const bf16_t* P = (const bf16_t*)(p.ws + W_P);
    bf16_t* QKV = (bf16_t*)(p.ws + W_QKV); float* BG = (float*)(p.ws + W_BG); bf16_t* LA = (bf16_t*)(p.ws + W_LA);
    bf16_t* CC = (bf16_t*)(p.ws + W_CC); bf16_t* SC = (bf16_t*)(p.ws + W_SC);
    const int tid = ltid();
    constexpr int GR = 16;
    const int ngr = ((s == 0) ? (MPR + NSAMP) : MPR) / GR;
    const float* cw = p.in[7];
    for (int g = blockIdx.x; g < ngr; g += gridDim.x) {
        const int r0 = g * GR; const bool samp = r0 >= MPR;
        const int b = samp ? (r0 - MPR) / NSS : r0 / TS, tt0 = samp ? (r0 - MPR) % NSS : r0 % TS, tlen = samp ? NSS : TS;
        const bool lastg = (tt0 == tlen - GR);
        unsigned raw[3][GR + 3]; float xf0[3][3], xf1[3][3];
        const int cmode = (tt0 > 0) ? 0 : (samp ? 1 : (s > 0 ? 2 : 3));
#pragma unroll
        for (int sec = 0; sec < 3; ++sec) { const int ch = sec * 1024 + 2 * tid;
#pragma unroll
            for (int q = 0; q < GR + 3; ++q) {
                if (q >= 3 || cmode == 0) raw[sec][q] = *(const unsigned*)(P + (size_t)(r0 - 3 + q) * NPAD + ch);
                else if (cmode == 2) raw[sec][q] = *(const unsigned*)(CC + ((size_t)((s & 1) * NB + b) * 3 + q) * 3072 + ch);
                else raw[sec][q] = 0u;
                if (q < 3) { xf0[sec][q] = 0.f; xf1[sec][q] = 0.f; if (cmode == 1) { const float* sp = p.in[2] + ((size_t)(b * 3 + q)) * 3072 + ch; xf0[sec][q] = sp[0]; xf1[sec][q] = sp[1]; } }
            } }
        float lpv[GR / 2], lprev[GR / 2];
#pragma unroll
        for (int e = 0; e < GR / 2; ++e) { const int item = tid + 512 * e, j = item >> 8, c = item & 255, col = 3072 + c;
            lpv[e] = bf2f(P[(size_t)(r0 + j) * NPAD + C_PB + col]);
            if (tt0 + j > 0) lprev[e] = bf2f(P[(size_t)(r0 + j - 1) * NPAD + C_PB + col]);
            else if (samp) lprev[e] = p.in[4][(size_t)b * CB + col];
            else if (s > 0) lprev[e] = bf2f(SC[((size_t)((s & 1) * NB + b)) * CB + col]);
            else lprev[e] = 0.f; }
#pragma unroll
        for (int sec = 0; sec < 3; ++sec) {
            const int ch = sec * 1024 + 2 * tid;
            float x0[GR + 3], x1[GR + 3];
#pragma unroll
            for (int q = 0; q < GR + 3; ++q) { x0[q] = bflo(raw[sec][q]); x1[q] = bfhi(raw[sec][q]); if (q < 3 && cmode == 1) { x0[q] = xf0[sec][q]; x1[q] = xf1[sec][q]; } }
            float w0[4], w1[4];
#pragma unroll
            for (int j = 0; j < 4; ++j) { w0[j] = cw[j * 3072 + ch]; w1[j] = cw[j * 3072 + ch + 1]; }
#pragma unroll
            for (int j = 0; j < GR; ++j) {
                float y0 = 0.f, y1 = 0.f;
#pragma unroll
                for (int t = 0; t < 4; ++t) { y0 += w0[t] * x0[j + t]; y1 += w1[t] * x1[j + t]; }
                y0 = siluf(y0); y1 = siluf(y1);
                if (sec < 2) { const float ss = wave_sum(y0 * y0 + y1 * y1); float rn = rsqrtf(ss + 1e-6f); if (sec == 0) rn *= 0.08838834764831845f; y0 *= rn; y1 *= rn; }
                *(unsigned*)(QKV + (size_t)(r0 + j) * 3072 + ch) = cvt_pk_bf16(y0, y1);
            }
            if (lastg) {
#pragma unroll
                for (int j = GR - 3; j < GR; ++j) { const int ci = j - (GR - 3);
                    if (!samp) { *(unsigned*)(CC + ((size_t)(((s + 1) & 1) * NB + b) * 3 + ci) * 3072 + ch) = raw[sec][j + 3];
                        if (s == NSEG - 1) { float* o = p.out + O_CP + ((size_t)(b * 3 + ci)) * 3072 + ch; o[0] = x0[j + 3]; o[1] = x1[j + 3]; } }
                    else { float* o = p.out + O_CS + ((size_t)(b * 3 + ci)) * 3072 + ch; o[0] = x0[j + 3]; o[1] = x1[j + 3]; }
                }
            }
        }
        if (tid < GR * 8) { const int j = tid >> 3, h = tid & 7; const bf16_t* Pr = P + (size_t)(r0 + j) * NPAD;
            const float br = bf2f(Pr[C_BETA + h]), ar = bf2f(Pr[C_AR + h]);
            BG[(size_t)(r0 + j) * 16 + h] = sigm(br); BG[(size_t)(r0 + j) * 16 + 8 + h] = -__expf(p.in[8][h]) * softplusf(ar + p.in[9][h]); }
#pragma unroll
        for (int e = 0; e < GR / 2; ++e) { const int item = tid + 512 * e, j = item >> 8, c = item & 255, col = 3072 + c;
            const float pv = lpv[e], prev = lprev[e];
            const float xs = pv + p.in[11][col] * (prev - pv);
            const float v = (c < 64) ? tanh_fast(xs) : ((c < 128) ? xs : sigm(xs));
            LA[(size_t)(r0 + j) * 256 + c] = f2bf(v); }
        if (lastg) { const bf16_t* Pr = P + (size_t)(r0 + GR - 1) * NPAD + C_PB;
            for (int c = tid; c < CB; c += 512) { const bf16_t v = Pr[c];
                if (!samp) { SC[((size_t)(((s + 1) & 1) * NB + b)) * CB + c] = v; if (s == NSEG - 1) p.out[O_SP + (size_t)b * CB + c] = bf2f(v); }
                else p.out[O_SS + (size_t)b * CB + c] = bf2f(v); } }
    }
}
template <int WHICH> __device__ __forceinline__ void ph_ln(const Params& p, int s) {
    float* PL = (float*)(p.ws + W_PL); bf16_t* hb = (bf16_t*)(p.ws + W_HB);
    const int tidl = ltid(); const int lane = tidl & 63, wave = tidl >> 6, nv = (s == 0) ? (MPR + NSAMP) : MPR;
    const float* gg = p.in[WHICH == 0 ? 23 : 27]; const float* bb = p.in[WHICH == 0 ? 24 : 28];
    f32x4 gv[4], bv[4];
#pragma unroll
    for (int j = 0; j < 4; ++j) { gv[j] = *(const f32x4*)(gg + (lane + 64 * j) * 4); bv[j] = *(const f32x4*)(bb + (lane + 64 * j) * 4); }
    const int stride = gridDim.x * 8;
    int r = blockIdx.x * 8 + wave;
    f32x4 v[4];
    if (r < nv) {
#pragma unroll
        for (int j = 0; j < 4; ++j) v[j] = *(const f32x4*)(PL + (size_t)r * 1024 + (lane + 64 * j) * 4); }
    for (; r < nv; r += stride) {
        float* xr = PL + (size_t)r * 1024;
        f32x4 vn[4];
#pragma unroll
        for (int j = 0; j < 4; ++j) vn[j] = v[j];
        if (r + stride < nv) {
#pragma unroll
            for (int j = 0; j < 4; ++j) vn[j] = *(const f32x4*)(PL + (size_t)(r + stride) * 1024 + (lane + 64 * j) * 4); }
        float sm = 0.f;
#pragma unroll
        for (int j = 0; j < 4; ++j) sm += (v[j][0] + v[j][1]) + (v[j][2] + v[j][3]);
        const float mean = wave_sum(sm) * (1.f / 1024.f); float s2 = 0.f;
#pragma unroll
        for (int j = 0; j < 4; ++j) { v[j] = v[j] - mean; s2 += (v[j][0] * v[j][0] + v[j][1] * v[j][1]) + (v[j][2] * v[j][2] + v[j][3] * v[j][3]); }
        const float rstd = rsqrtf(wave_sum(s2) * (1.f / 1024.f) + 1e-5f);
        float* yo = (WHICH == 0) ? xr : yrow_ptr(p, r, s);
#pragma unroll
        for (int j = 0; j < 4; ++j) { const f32x4 o = v[j] * rstd * gv[j] + bv[j]; *(f32x4*)(yo + (lane + 64 * j) * 4) = o;
            if (WHICH == 0) { u32x2 w; w.x = cvt_pk_bf16(o[0], o[1]); w.y = cvt_pk_bf16(o[2], o[3]); *(u32x2*)(hb + (size_t)r * 1024 + (lane + 64 * j) * 4) = w; } }
#pragma unroll
        for (int j = 0; j < 4; ++j) v[j] = vn[j];
    }
}
__device__ __forceinline__ void ph_gdnpre(const Params& p, lds_t L, int s) {
    const bf16_t* QKV = (const bf16_t*)(p.ws + W_QKV); const float* BG = (const float*)(p.ws + W_BG);
    bf16_t* Tm = (bf16_t*)(p.ws + W_T); float* GC = (float*)(p.ws + W_GC);
    const int tidl = ltid(); const int lane = tidl & 63, wave = tidl >> 6, l15 = lane & 15, lq = lane >> 4;
    LAS float* Af = (LAS float*)(L + wave * 16896); LAS float* gcs = Af + 4096; LAS float* bts = gcs + 64;
    const int ni = (s == 0) ? NITEM : NITEM_P;
    for (int it = blockIdx.x * 8 + wave; it < ni; it += gridDim.x * 8) {
        int row0, h, nvalid;
        if (it < NITEM_P) { const int b = it >> 6, ck = (it >> 3) & 7; h = it & 7; row0 = b * TS + ck * 64; nvalid = 64; }
        else { const int j = it - NITEM_P; h = j & 7; row0 = MPR + (j >> 3) * NSS; nvalid = NSS; }
        float g = 0.f, bt = 0.f;
        if (lane < nvalid) { g = BG[(size_t)(row0 + lane) * 16 + 8 + h]; bt = BG[(size_t)(row0 + lane) * 16 + h]; }
#pragma unroll
        for (int o = 1; o < 64; o <<= 1) { const float t = __shfl_up(g, o); if (lane >= o) g += t; }
        gcs[lane] = g; bts[lane] = bt;
        f32x4 acc[4][4];
#pragma unroll
        for (int I = 0; I < 4; ++I)
#pragma unroll
            for (int J = 0; J < 4; ++J) acc[I][J] = (f32x4){0.f, 0.f, 0.f, 0.f};
#pragma unroll
        for (int kk = 0; kk < 4; ++kk) {
            bf16x8 fr[4];
#pragma unroll
            for (int I = 0; I < 4; ++I) { const int row = 16 * I + l15; u32x4 v = (u32x4){0u, 0u, 0u, 0u};
                if (row < nvalid) v = *(const u32x4*)(QKV + (size_t)(row0 + row) * 3072 + 1024 + h * 128 + kk * 32 + 8 * lq);
                fr[I] = __builtin_bit_cast(bf16x8, v); }
#pragma unroll
            for (int I = 0; I < 4; ++I)
#pragma unroll
                for (int J = 0; J <= I; ++J) acc[I][J] = mfma16(fr[I], fr[J], acc[I][J]);
            asm volatile("" ::: "memory");
        }
        asm volatile("s_waitcnt lgkmcnt(0)" ::: "memory");
#pragma unroll
        for (int I = 0; I < 4; ++I)
#pragma unroll
            for (int J = 0; J < 4; ++J)
#pragma unroll
                for (int jj = 0; jj < 4; ++jj) { const int i = 16 * I + 4 * lq + jj, j = 16 * J + l15;
                    float val = 0.f; if (J <= I && i > j) val = bts[i] * acc[I][J][jj] * __expf(gcs[i] - gcs[j]);
                    Af[i * 64 + j] = val; }
        asm volatile("s_waitcnt lgkmcnt(0)" ::: "memory");
        float t[64];
        int ll = lane; asm volatile("" : "+v"(ll));
#pragma unroll
        for (int i = 0; i < 64; ++i) {
            float a0 = (ll == i) ? 1.f : 0.f, a1 = 0.f;
#pragma unroll
            for (int j4 = 0; j4 < i; j4 += 4) { const f32x4 av = *(const LAS f32x4*)(Af + i * 64 + j4);
                a0 -= av[0] * t[j4]; if (j4 + 1 < i) a1 -= av[1] * t[j4 + 1]; if (j4 + 2 < i) a0 -= av[2] * t[j4 + 2]; if (j4 + 3 < i) a1 -= av[3] * t[j4 + 3]; }
            t[i] = a0 + a1;
            asm volatile("" ::: "memory");
        }
        const float sb = bts[lane], sg = sb * __expf(gcs[lane]);
        const float gcl = gcs[lane];
        asm volatile("s_waitcnt lgkmcnt(0)" ::: "memory");
        LAS bf16_t* TL = (LAS bf16_t*)Af;
#pragma unroll
        for (int i = 0; i < 64; ++i) { TL[i * 64 + lane] = f2bf(t[i] * sb); TL[4096 + i * 64 + lane] = f2bf(t[i] * sg); if ((i & 3) == 3) asm volatile("" ::: "memory"); }
        asm volatile("s_waitcnt lgkmcnt(0)" ::: "memory");
        bf16_t* Tb = Tm + (size_t)it * 8192;
#pragma unroll
        for (int q = 0; q < 16; ++q) *(u32x4*)(Tb + (size_t)(lane + 64 * q) * 8) = *(const LAS u32x4*)(TL + (lane + 64 * q) * 8);
        GC[(size_t)it * 64 + lane] = gcl;
        asm volatile("s_waitcnt lgkmcnt(0)" ::: "memory");
    }
}

constexpr int G_QH = 0, G_KH = 17408, G_KT = 34816, G_VT = 53248, G_VS = 71680, G_TB = 90112, G_TG = 99328, G_QK = 108544, G_SB = 117760, G_SM = 152576;
__device__ __forceinline__ int tofs(int r, int c) { return (r * 72 + c) * 2; }
#define LFRAG(off) (*(const LAS bf16x8*)(L + (off)))
__device__ __forceinline__ void gdn_seq(const Params& p, lds_t L, int row0, int nchunks, int nvalid, int item0, int h, const float* Sin, float* Sout) {
    const bf16_t* P = (const bf16_t*)(p.ws + W_P); const bf16_t* QKV = (const bf16_t*)(p.ws + W_QKV);
    const bf16_t* Tm = (const bf16_t*)(p.ws + W_T); const float* GC = (const float*)(p.ws + W_GC); bf16_t* MG = (bf16_t*)(p.ws + W_MG);
    const int tid = ltid(), lane = tid & 63, wave = tid >> 6, l15 = lane & 15, lq = lane >> 4;
    LAS float* SM = (LAS float*)(L + G_SM);
    f32x4 accS[8];
#pragma unroll
    for (int kt = 0; kt < 8; ++kt) { accS[kt] = (f32x4){0.f, 0.f, 0.f, 0.f}; if (Sin) accS[kt] = *(const f32x4*)(Sin + (size_t)(16 * kt + l15) * 128 + 16 * wave + 4 * lq); }
    const float ng0 = p.in[10][2 * lane], ng1 = p.in[10][2 * lane + 1];
    u32x4 pq[2], pk[2], pv[2], ptb, ptg; float pgc, pgl;
    auto gload = [&](int c) {
        const int r0n = row0 + c * 64, itn = item0 + c * 8;
        int tl2 = tid; asm volatile("" : "+v"(tl2));
        const int ln = tl2 & 63, wv = tl2 >> 6;
#pragma unroll
        for (int e = 0; e < 2; ++e) { const int c8 = (wv * 2 + e) * 8;
            pq[e] = (u32x4){0u, 0u, 0u, 0u}; pk[e] = pq[e]; pv[e] = pq[e];
            if (ln < nvalid) { const bf16_t* src = QKV + (size_t)(r0n + ln) * 3072 + h * 128 + c8; pq[e] = *(const u32x4*)src; pk[e] = *(const u32x4*)(src + 1024); pv[e] = *(const u32x4*)(src + 2048); } }
        { const int row = tl2 >> 3, c8 = (tl2 & 7) * 8; const bf16_t* src = Tm + (size_t)itn * 8192 + row * 64 + c8; ptb = *(const u32x4*)src; ptg = *(const u32x4*)(src + 4096); }
        pgc = GC[(size_t)itn * 64 + ln]; pgl = GC[(size_t)itn * 64 + 63];
    };
    gload(0);
    for (int ck = 0; ck < nchunks; ++ck) {
        const int r0 = row0 + ck * 64, item = item0 + ck * 8;
        int tl_ = tid; asm volatile("" : "+v"(tl_));
        const int lane = tl_ & 63, wave = tl_ >> 6, l15 = lane & 15, lq = lane >> 4;
#pragma unroll
        for (int e = 0; e < 2; ++e) {
            const int row = lane, c8 = (wave * 2 + e) * 8;
            const u32x4 q = pq[e], k = pk[e], v = pv[e];
            *(LAS u32x4*)(L + G_QH + (row * 136 + c8) * 2) = q;
            *(LAS u32x4*)(L + G_KH + (row * 136 + c8) * 2) = k;
#pragma unroll
            for (int x = 0; x < 4; ++x) {
                *(LAS bf16_t*)(L + G_KT + tofs(c8 + 2 * x, row)) = (bf16_t)(k[x] & 0xffffu); *(LAS bf16_t*)(L + G_KT + tofs(c8 + 2 * x + 1, row)) = (bf16_t)(k[x] >> 16);
                *(LAS bf16_t*)(L + G_VT + tofs(c8 + 2 * x, row)) = (bf16_t)(v[x] & 0xffffu); *(LAS bf16_t*)(L + G_VT + tofs(c8 + 2 * x + 1, row)) = (bf16_t)(v[x] >> 16);
            }
        }
        { const int row = tid >> 3, c8 = (tid & 7) * 8;
          *(LAS u32x4*)(L + G_TB + (row * 72 + c8) * 2) = ptb; *(LAS u32x4*)(L + G_TG + (row * 72 + c8) * 2) = ptg; }
        if (tid < 64) { const float gcv = pgc, gl = pgl;
            SM[tid] = gcv; SM[64 + tid] = __expf(gcv); SM[128 + tid] = __expf(gl - gcv); if (tid == 0) SM[192] = __expf(gl); }
        if (ck + 1 < nchunks) gload(ck + 1);
        if (ck == 0) {
#pragma unroll
            for (int kt = 0; kt < 8; ++kt)
#pragma unroll
                for (int jj = 0; jj < 4; ++jj) *(LAS bf16_t*)(L + G_SB + ((16 * wave + 4 * lq + jj) * 136 + 16 * kt + l15) * 2) = f2bf(accS[kt][jj]);
        }
        lds_barrier();
        {
            const int tI = wave >> 1;
#pragma unroll
            for (int x = 0; x < 2; ++x) { const int tJ = 2 * (wave & 1) + x; f32x4 a = (f32x4){0.f, 0.f, 0.f, 0.f};
                if (tJ <= tI) {
#pragma unroll
                    for (int kk = 0; kk < 4; ++kk) a = mfma16(LFRAG(G_QH + ((16 * tI + l15) * 136 + kk * 32 + 8 * lq) * 2), LFRAG(G_KH + ((16 * tJ + l15) * 136 + kk * 32 + 8 * lq) * 2), a); }
#pragma unroll
                for (int jj = 0; jj < 4; ++jj) { const int i = 16 * tI + 4 * lq + jj, j = 16 * tJ + l15;
                    const float val = (i >= j) ? a[jj] * __expf(SM[i] - SM[j]) : 0.f;
                    *(LAS bf16_t*)(L + G_QK + (i * 72 + j) * 2) = f2bf(val); } }
        }
        f32x4 accU[4], accW[4];
#pragma unroll
        for (int ct = 0; ct < 4; ++ct) { accU[ct] = (f32x4){0.f, 0.f, 0.f, 0.f}; accW[ct] = accU[ct];
#pragma unroll
            for (int js = 0; js < 2; ++js) {
                accU[ct] = mfma16(LFRAG(G_VT + tofs(16 * wave + l15, js * 32 + 8 * lq)), LFRAG(G_TB + ((16 * ct + l15) * 72 + js * 32 + 8 * lq) * 2), accU[ct]);
                accW[ct] = mfma16(LFRAG(G_TG + ((16 * ct + l15) * 72 + js * 32 + 8 * lq) * 2), LFRAG(G_KT + tofs(16 * wave + l15, js * 32 + 8 * lq)), accW[ct]); }
            asm volatile("" ::: "memory"); }
        lds_barrier();
#pragma unroll
        for (int ct = 0; ct < 4; ++ct)
#pragma unroll
            for (int jj = 0; jj < 4; ++jj) *(LAS bf16_t*)(L + G_KH + ((16 * ct + 4 * lq + jj) * 136 + 16 * wave + l15) * 2) = f2bf(-accW[ct][jj]);
        lds_barrier();
        unsigned zz8[8], ga8[8];
#pragma unroll
        for (int q = 0; q < 8; ++q) { const int c = wave + 8 * q; zz8[q] = 0u; ga8[q] = 0u;
            if (c < nvalid) { const size_t row = (size_t)(r0 + c); const int col = h * 128 + 2 * lane; zz8[q] = *(const unsigned*)(P + row * NPAD + C_Z + col); ga8[q] = *(const unsigned*)(P + row * NPAD + C_GA + col); } }
        f32x4 accO[4];
        {
            bf16x8 sf[4];
#pragma unroll
            for (int ks = 0; ks < 4; ++ks) sf[ks] = LFRAG(G_SB + ((16 * wave + l15) * 136 + ks * 32 + 8 * lq) * 2);
#pragma unroll
            for (int ct = 0; ct < 4; ++ct) { accO[ct] = (f32x4){0.f, 0.f, 0.f, 0.f};
#pragma unroll
                for (int ks = 0; ks < 4; ++ks) {
                    accU[ct] = mfma16(sf[ks], LFRAG(G_KH + ((16 * ct + l15) * 136 + ks * 32 + 8 * lq) * 2), accU[ct]);
                    accO[ct] = mfma16(sf[ks], LFRAG(G_QH + ((16 * ct + l15) * 136 + ks * 32 + 8 * lq) * 2), accO[ct]); }
                const int c = 16 * ct + l15; const float ec = SM[128 + c], eg = SM[64 + c];
#pragma unroll
                for (int jj = 0; jj < 4; ++jj) { const int v = 16 * wave + 4 * lq + jj;
                    *(LAS bf16_t*)(L + G_VT + tofs(v, c)) = f2bf(accU[ct][jj]); *(LAS bf16_t*)(L + G_VS + tofs(v, c)) = f2bf(accU[ct][jj] * ec);
                    accO[ct][jj] *= eg; }
                asm volatile("" ::: "memory"); }
        }
        lds_barrier();
        {
            bf16x8 vf[2], vsf[2];
#pragma unroll
            for (int js = 0; js < 2; ++js) { vf[js] = LFRAG(G_VT + tofs(16 * wave + l15, js * 32 + 8 * lq)); vsf[js] = LFRAG(G_VS + tofs(16 * wave + l15, js * 32 + 8 * lq)); }
#pragma unroll
            for (int ct = 0; ct < 4; ++ct) {
#pragma unroll
                for (int js = 0; js < 2; ++js) accO[ct] = mfma16(vf[js], LFRAG(G_QK + ((16 * ct + l15) * 72 + js * 32 + 8 * lq) * 2), accO[ct]);
                *(LAS f32x4*)(L + ((16 * ct + l15) * 132 + 16 * wave + 4 * lq) * 4) = accO[ct];
                asm volatile("" ::: "memory"); }
            const float egl = SM[192];
#pragma unroll
            for (int kt = 0; kt < 8; ++kt) { accS[kt] = accS[kt] * egl;
#pragma unroll
                for (int js = 0; js < 2; ++js) accS[kt] = mfma16(vsf[js], LFRAG(G_KT + tofs(16 * kt + l15, js * 32 + 8 * lq)), accS[kt]);
#pragma unroll
                for (int jj = 0; jj < 4; ++jj) *(LAS bf16_t*)(L + G_SB + ((16 * wave + 4 * lq + jj) * 136 + 16 * kt + l15) * 2) = f2bf(accS[kt][jj]);
                asm volatile("" ::: "memory"); }
        }
        lds_barrier();
#pragma unroll
        for (int q = 0; q < 8; ++q) { const int c = wave + 8 * q;
            if (c < nvalid) {
                const f32x2 o = *(const LAS f32x2*)(L + (c * 132 + 2 * lane) * 4);
                const float ss = wave_sum(o[0] * o[0] + o[1] * o[1]); const float rinv = rsqrtf(ss * (1.f / 128.f) + 1e-6f);
                const size_t row = (size_t)(r0 + c); const int col = h * 128 + 2 * lane;
                const unsigned zz = zz8[q], ga = ga8[q];
                const float o0 = o[0] * rinv * ng0 * siluf(bflo(zz)) * sigm(bflo(ga)), o1 = o[1] * rinv * ng1 * siluf(bfhi(zz)) * sigm(bfhi(ga));
                *(unsigned*)(MG + row * 1024 + col) = cvt_pk_bf16(o0, o1); } }
        lds_barrier();
    }
    { int so = l15 * 128 + 16 * wave + 4 * lq; asm volatile("" : "+v"(so));
#pragma unroll
      for (int kt = 0; kt < 8; ++kt) *(f32x4*)(Sout + (size_t)(so + kt * 2048)) = accS[kt]; }
}
constexpr int R_OP = 57344, R_YB = 114688;
__device__ __forceinline__ void rwkv_seq(const Params& p, lds_t L, int s, int rbase, int T, bool samp, int b, int h, const float* Sin, float* Sout) {
    const bf16_t* P = (const bf16_t*)(p.ws + W_P); const bf16_t* LR = (const bf16_t*)(p.ws + W_L); bf16_t* MG = (bf16_t*)(p.ws + W_MG);
    const bf16_t* SC = (const bf16_t*)(p.ws + W_SC);
    const int tid = ltid(), lane = tid & 63, wave = tid >> 6;
    const int NT = (T + 15) / 16;
    const bool scanner = wave < 4;
    typedef float f32x16 __attribute__((ext_vector_type(16)));
    const int hh_s = wave >> 1, half = wave & 1, cl = lane & 31, hf = lane >> 5;
    f32x16 T0, T1;
    const int hh_l = wave & 1, st0 = (wave < 4) ? 2 * (wave >> 1) : 4 + 6 * ((wave - 4) >> 1);
    const int hg_s = 2 * h + hh_s;
    const int hg = 2 * h + hh_l;
    const int hc = hg * 64 + lane;
    const size_t lbase = samp ? ((size_t)MPR * 3072 + (size_t)((b * 8 + h) * NSS) * 384) : ((size_t)((b * 8 + h) * TS) * 384);
    float c_mur = 0.f, c_muk = 0.f, c_muv = 0.f, c_w0 = 0.f, c_a0 = 0.f, c_kk = 0.f, c_ka = 0.f, c_rk = 0.f, c_lg = 0.f, c_lb = 0.f, c_pr = 0.f, c_pk = 0.f, c_pv = 0.f;
    if (scanner) {
#pragma unroll
        for (int g = 0; g < 4; ++g) { f32x4 t0 = (f32x4){0.f, 0.f, 0.f, 0.f}, t1 = t0;
            if (Sin) { const float* sp = Sin + ((size_t)hg_s * 64 + 32 * half + cl) * 64 + 8 * g + 4 * hf; t0 = *(const f32x4*)sp; t1 = *(const f32x4*)(sp + 32); }
#pragma unroll
            for (int q = 0; q < 4; ++q) { T0[4 * g + q] = t0[q]; T1[4 * g + q] = t1[q]; } }
        float one = 1.0f; asm volatile("" : "+v"(one)); T0 *= one; T1 *= one;
    }
    {
        if (samp) { c_pr = p.in[4][(size_t)b * CB + hc]; c_pk = p.in[4][(size_t)b * CB + 1024 + hc]; c_pv = p.in[4][(size_t)b * CB + 2048 + hc]; }
        else if (s > 0) { const bf16_t* sc = SC + ((size_t)((s & 1) * NB + b)) * CB; c_pr = bf2f(sc[hc]); c_pk = bf2f(sc[1024 + hc]); c_pv = bf2f(sc[2048 + hc]); }
    }
    typedef unsigned short us2 __attribute__((ext_vector_type(2)));
    struct RawA { us2 rk[6], vl[6], ll[6], q0, q1; };
    struct RawB { us2 go[6]; };
    auto issueA = [&](auto nqc, int nl, RawA& a) {
        constexpr int NQ = decltype(nqc)::value;
        const int tb = nl * 16 + st0;
#pragma unroll
        for (int q = 0; q < NQ; ++q) { const size_t row = (size_t)(rbase + tb + q); const bf16_t* Pr = P + row * NPAD + C_PB; const bf16_t* Lr = LR + lbase + (size_t)((tb + q) * 2 + hh_l) * 192 + lane;
            a.rk[q].x = Pr[hc]; a.rk[q].y = Pr[1024 + hc]; a.vl[q].x = Pr[2048 + hc]; a.vl[q].y = Lr[0]; a.ll[q].x = Lr[64]; a.ll[q].y = Lr[128]; }
        if (tb > 0) { const bf16_t* Pq = P + (size_t)(rbase + tb - 1) * NPAD + C_PB; a.q0.x = Pq[hc]; a.q0.y = Pq[1024 + hc]; a.q1.x = Pq[2048 + hc]; a.q1.y = 0; }
        else { a.q0.x = 0; a.q0.y = 0; a.q1.x = 0; a.q1.y = 1; }
    };
    auto issueB = [&](auto nqc, int np, RawB& bq) {
        constexpr int NQ = decltype(nqc)::value;
        const int tb = np * 16 + st0;
#pragma unroll
        for (int q = 0; q < NQ; ++q) { const size_t row = (size_t)(rbase + tb + q); bq.go[q].x = P[row * NPAD + C_GB + hc]; bq.go[q].y = MG[row * 1024 + hc]; }
    };
    auto postcalc = [&](auto nqc, int np, float (&outv)[6]) {
        constexpr int NQ = decltype(nqc)::value;
        int hl = hc; asm volatile("" : "+v"(hl));
        const float c_rk = p.in[19][hl], c_lg = p.in[20][hl], c_lb = p.in[21][hl];
        const LAS float* OP = (const LAS float*)(L + (np & 1) * R_OP); const LAS float* YB = (const LAS float*)(L + R_YB + (np & 1) * 8192);
        float y[NQ], m[NQ], bs[NQ], vq[NQ], gq[NQ];
#pragma unroll
        for (int q = 0; q < NQ; ++q) { const int tt = st0 + q; const LAS float* o = OP + ((hh_l * 16 + tt) * 7) * 64 + lane;
            y[q] = YB[(hh_l * 16 + tt) * 64 + lane]; m[q] = y[q]; bs[q] = o[256] * o[192] * c_rk; vq[q] = o[320]; gq[q] = o[384]; }
        wave_sumN<NQ>(m); wave_sumN<NQ>(bs);
        float d[NQ], var[NQ];
#pragma unroll
        for (int q = 0; q < NQ; ++q) { d[q] = y[q] - m[q] * (1.f / 64.f); var[q] = d[q] * d[q]; }
        wave_sumN<NQ>(var);
#pragma unroll
        for (int q = 0; q < NQ; ++q) { const float yn = d[q] * rsqrtf(var[q] * (1.f / 64.f) + 64e-5f) * c_lg + c_lb; outv[q] = (yn + bs[q] * vq[q]) * gq[q]; }
    };
    auto postwrite = [&](auto nqc, int np, const RawB& bq, const float (&outv)[6]) {
        constexpr int NQ = decltype(nqc)::value;
        const int tb = np * 16 + st0;
        float eg[NQ];
#pragma unroll
        for (int q = 0; q < NQ; ++q) eg[q] = __expf(-bf2f(bq.go[q].x));
#pragma unroll
        for (int q = 0; q < NQ; ++q) eg[q] = __builtin_amdgcn_rcpf(1.0f + eg[q]);
#pragma unroll
        for (int q = 0; q < NQ; ++q) { const size_t row = (size_t)(rbase + tb + q); MG[row * 1024 + hc] = f2bf(bf2f(bq.go[q].y) + eg[q] * outv[q]); }
    };
    auto transform = [&](auto nqc, int nl, const RawA& a) {
        constexpr int NQ = decltype(nqc)::value;
        LAS float* OP = (LAS float*)(L + (nl & 1) * R_OP);
        int hl = hc; asm volatile("" : "+v"(hl));
        const float c_mur = p.in[11][hl], c_muk = p.in[11][1024 + hl], c_muv = p.in[11][2048 + hl], c_w0 = p.in[12][hl], c_a0 = p.in[14][hl], c_kk = p.in[17][hl], c_ka = p.in[18][hl];
        float qr = c_pr, qk = c_pk, qv = c_pv;
        if (a.q1.y == 0) { qr = bf2f(a.q0.x); qk = bf2f(a.q0.y); qv = bf2f(a.q1.x); }
        float xr[NQ], xk[NQ], xv[NQ], kkv[NQ], ss[NQ], e1[NQ], e2[NQ];
#pragma unroll
        for (int q = 0; q < NQ; ++q) { const float pr = bf2f(a.rk[q].x), pk = bf2f(a.rk[q].y), pv = bf2f(a.vl[q].x);
            xr[q] = pr + c_mur * (qr - pr); xk[q] = pk + c_muk * (qk - pk); xv[q] = pv + c_muv * (qv - pv); qr = pr; qk = pk; qv = pv;
            kkv[q] = xk[q] * c_kk; ss[q] = kkv[q] * kkv[q]; }
        wave_sumN<NQ>(ss);
#pragma unroll
        for (int q = 0; q < NQ; ++q) { e1[q] = __expf(-(c_w0 + bf2f(a.vl[q].y))); e2[q] = __expf(-(c_a0 + bf2f(a.ll[q].x))); }
        float sw[NQ], asig[NQ], rn[NQ];
#pragma unroll
        for (int q = 0; q < NQ; ++q) { sw[q] = __builtin_amdgcn_rcpf(1.0f + e1[q]); asig[q] = __builtin_amdgcn_rcpf(1.0f + e2[q]); rn[q] = rsqrtf(ss[q] + 1e-6f); }
        float dec[NQ];
#pragma unroll
        for (int q = 0; q < NQ; ++q) dec[q] = __expf(-0.6065306597126334f * sw[q]);
#pragma unroll
        for (int q = 0; q < NQ; ++q) { const int tt = st0 + q; const float kk = kkv[q] * rn[q]; const float kmod = xk[q] * (1.f + (asig[q] - 1.f) * c_ka);
            LAS float* o = OP + ((hh_l * 16 + tt) * 7) * 64 + lane;
            o[0] = dec[q]; o[64] = -kk; o[128] = kk * asig[q]; o[192] = kmod; o[256] = xr[q]; o[320] = xv[q]; o[384] = bf2f(a.ll[q].y); }
    };
    auto scan_tile = [&](const LAS float* OP, LAS float* YB) {
        const int roff = 4 * hf;
        const int abase = (hf ? 192 : 128) + cl;
        float yp_prev = 0.f, yo_prev = 0.f;
        for (int tt = 0; tt < 16; ++tt) {
            const LAS float* op = OP + ((hh_s * 16 + tt) * 7) * 64;
            f32x4 ar[2][4], wr[2][4], rr[2][4];
#pragma unroll
            for (int jb = 0; jb < 2; ++jb)
#pragma unroll
                for (int g = 0; g < 4; ++g) ar[jb][g] = *(const LAS f32x4*)(op + 64 + 32 * jb + 8 * g + roff);
#pragma unroll
            for (int jb = 0; jb < 2; ++jb)
#pragma unroll
                for (int g = 0; g < 4; ++g) { wr[jb][g] = *(const LAS f32x4*)(op + 32 * jb + 8 * g + roff); rr[jb][g] = *(const LAS f32x4*)(op + 256 + 32 * jb + 8 * g + roff); }
            const float aop0 = op[abase], aop1 = op[abase + 32], vv = op[320 + 32 * half + cl];
            f32x4 acc = (f32x4){0.f, 0.f, 0.f, 0.f}, acd = acc;
#pragma unroll
            for (int g = 0; g < 4; ++g) { const f32x4 t0 = (f32x4){T0[4 * g], T0[4 * g + 1], T0[4 * g + 2], T0[4 * g + 3]}, t1 = (f32x4){T1[4 * g], T1[4 * g + 1], T1[4 * g + 2], T1[4 * g + 3]};
                acc += t0 * ar[0][g]; acd += t1 * ar[1][g]; }
            acc += acd;
            const float part = (acc[0] + acc[1]) + (acc[2] + acc[3]);
            const float other = __shfl_xor(part, 32);
#pragma unroll
            for (int g = 0; g < 4; ++g)
#pragma unroll
                for (int q = 0; q < 4; ++q) { T0[4 * g + q] *= wr[0][g][q]; T1[4 * g + q] *= wr[1][g][q]; }
            if (tt > 0 && hf == 0) YB[(hh_s * 16 + tt - 1) * 64 + 32 * half + cl] = yp_prev + yo_prev;
            const float sa = part + other;
            const float bop = hf ? vv : sa;
            T0 = __builtin_amdgcn_mfma_f32_32x32x2f32(aop0, bop, T0, 0, 0, 0);
            T1 = __builtin_amdgcn_mfma_f32_32x32x2f32(aop1, bop, T1, 0, 0, 0);
            f32x4 yc = (f32x4){0.f, 0.f, 0.f, 0.f}, yd = yc;
#pragma unroll
            for (int g = 0; g < 4; ++g) { const f32x4 t0 = (f32x4){T0[4 * g], T0[4 * g + 1], T0[4 * g + 2], T0[4 * g + 3]}, t1 = (f32x4){T1[4 * g], T1[4 * g + 1], T1[4 * g + 2], T1[4 * g + 3]};
                yc += t0 * rr[0][g]; yd += t1 * rr[1][g]; }
            yc += yd;
            yp_prev = (yc[0] + yc[1]) + (yc[2] + yc[3]);
            yo_prev = __shfl_xor(yp_prev, 32);
        }
        if (hf == 0) YB[(hh_s * 16 + 15) * 64 + 32 * half + cl] = yp_prev + yo_prev;
    };
    auto work = [&](auto nqc, int n, RawA& Acur, RawA& Anext) {
        RawB Bq; float outv[6];
        if (scanner) { const LAS float* OP = (const LAS float*)(L + (n & 1) * R_OP); LAS float* YB = (LAS float*)(L + R_YB + (n & 1) * 8192); scan_tile(OP, YB); }
        if (n >= 1) issueB(nqc, n - 1, Bq);
        if (n + 2 < NT) issueA(nqc, n + 2, Anext);
        if (n >= 1) postcalc(nqc, n - 1, outv);
        if (n + 1 < NT) transform(nqc, n + 1, Acur);
        if (n >= 1) postwrite(nqc, n - 1, Bq, outv);
    };
    auto iter = [&](int n, RawA& Acur, RawA& Anext) {
        if (scanner) work(IC<2>{}, n, Acur, Anext); else work(IC<6>{}, n, Acur, Anext);
        lds_barrier();
    };
    RawA A0, A1;
    if (scanner) { issueA(IC<2>{}, 0, A1); transform(IC<2>{}, 0, A1); if (NT > 1) issueA(IC<2>{}, 1, A0); }
    else { issueA(IC<6>{}, 0, A1); transform(IC<6>{}, 0, A1); if (NT > 1) issueA(IC<6>{}, 1, A0); }
    __syncthreads();
    for (int n = 0; n < NT; n += 2) {
        iter(n, A0, A1);
        if (n + 1 < NT) iter(n + 1, A1, A0);
    }
    { RawB Bq; float outv[6];
      if (scanner) { issueB(IC<2>{}, NT - 1, Bq); postcalc(IC<2>{}, NT - 1, outv); postwrite(IC<2>{}, NT - 1, Bq, outv); }
      else { issueB(IC<6>{}, NT - 1, Bq); postcalc(IC<6>{}, NT - 1, outv); postwrite(IC<6>{}, NT - 1, Bq, outv); } }
    if (scanner) {
#pragma unroll
        for (int g = 0; g < 4; ++g) { float* sp = Sout + ((size_t)hg_s * 64 + 32 * half + cl) * 64 + 8 * g + 4 * hf;
            *(f32x4*)sp = (f32x4){T0[4 * g], T0[4 * g + 1], T0[4 * g + 2], T0[4 * g + 3]}; *(f32x4*)(sp + 32) = (f32x4){T1[4 * g], T1[4 * g + 1], T1[4 * g + 2], T1[4 * g + 3]}; }
    }
    __syncthreads();
}

__device__ __forceinline__ void ph_seq(const Params& p, lds_t L, int s) {
    for (int blk = blockIdx.x; blk < NB * 8; blk += gridDim.x) {
        const int b = blk >> 3, h = blk & 7;
        float* gst = p.out + O_GP + ((size_t)(b * 8 + h)) * 16384;
#ifndef NO_GDN
        gdn_seq(p, L, b * TS, TS / 64, 64, (b << 6) + h, h, s > 0 ? gst : nullptr, gst);
#endif
        float* wst = p.out + O_WP + (size_t)b * 16 * 4096;
#ifndef NO_RWKV
        rwkv_seq(p, L, s, b * TS, TS, false, b, h, s > 0 ? wst : nullptr, wst);
#endif
    }
#ifndef NO_SAMP
    if (s == 0) for (int blk = blockIdx.x; blk < NSB * 8; blk += gridDim.x) {
        const int sb = blk >> 3, h = blk & 7;
        gdn_seq(p, L, MPR + sb * NSS, 1, NSS, NITEM_P + blk, h, p.in[3] + ((size_t)(sb * 8 + h)) * 16384, p.out + O_GS + ((size_t)(sb * 8 + h)) * 16384);
        rwkv_seq(p, L, s, MPR + sb * NSS, NSS, true, sb, h, p.in[5] + (size_t)sb * 16 * 4096, p.out + O_WS + (size_t)sb * 16 * 4096);
    }
#endif
}

#ifdef ONLY
#define EN(x) ((x) == ONLY)
#elif defined(ENMASK)
#define EN(x) (((ENMASK) >> ((x) == 100 ? 11 : (x))) & 1)
#else
#define EN(x) true
#endif

template <int MODE> __device__ __forceinline__ void skinny_gemm(const Params& p, lds_t L, const bf16_t* A, int lda, const bf16_t* Bt, int ldb, int N, int K) {
    const int tid = ltid(), lane = tid & 63, wave = tid >> 6, l15 = lane & 15, lq = lane >> 4;
    LAS float* red = (LAS float*)L;
    const int ntile = 8 * (N / 16), kw = K / 8;
    float* PL = (float*)(p.ws + W_PL); bf16_t* Fb = (bf16_t*)(p.ws + W_P);
    for (int t = blockIdx.x; t < ntile; t += gridDim.x) {
        const int tr = t & 7, tc = t >> 3;
        const bf16_t* ap = A + (size_t)(16 * tr + l15) * lda + wave * kw + 8 * lq;
        const bf16_t* bp = Bt + (size_t)(16 * tc + l15) * ldb + wave * kw + 8 * lq;
        f32x4 acc = (f32x4){0.f, 0.f, 0.f, 0.f};
        for (int k0 = 0; k0 < kw; k0 += 128) {
            u32x4 af[4], bf[4];
#pragma unroll
            for (int u = 0; u < 4; ++u) { af[u] = *(const u32x4*)(ap + k0 + 32 * u); bf[u] = *(const u32x4*)(bp + k0 + 32 * u); }
#pragma unroll
            for (int u = 0; u < 4; ++u) acc = mfma16(__builtin_bit_cast(bf16x8, af[u]), __builtin_bit_cast(bf16x8, bf[u]), acc);
        }
#pragma unroll
        for (int jj = 0; jj < 4; ++jj) red[wave * 256 + (4 * lq + jj) * 16 + l15] = acc[jj];
        __syncthreads();
        if (tid < 256) {
            float v = 0.f;
#pragma unroll
            for (int w = 0; w < 8; ++w) v += red[w * 256 + tid];
            const int r = 16 * tr + (tid >> 4), c = 16 * tc + (tid & 15); const size_t row = (size_t)(MPR + r);
            if (MODE == 0) PL[row * 1024 + c] = v + DN_ALPHA * p.in[1][(size_t)r * D + c];
            else if (MODE == 1) { const float a = fmaxf(v, 0.f); Fb[row * LDF + c] = f2bf(a * a); }
            else PL[row * 1024 + c] = v + DN_ALPHA * PL[row * 1024 + c];
        }
        __syncthreads();
    }
}
#define XB_TMO      128
#define XB_XCNT(j)  (256  + 64 * (j))
#define XB_XSUB(j)  (1280 + 64 * (j))
#define XB_XGEN(j)  (2304 + 64 * (j))
#define XB_TOP      3328
#define XB_TOPGEN   3392
#define XCD_BAR_WORDS 3456
#define XB_SPIN_CAP (1u << 20)
__device__ __forceinline__ unsigned xb_ld(unsigned* p)              { return __hip_atomic_load(p, __ATOMIC_RELAXED, __HIP_MEMORY_SCOPE_AGENT); }
__device__ __forceinline__ unsigned xb_add(unsigned* p, unsigned v) { return __hip_atomic_fetch_add(p, v, __ATOMIC_RELAXED, __HIP_MEMORY_SCOPE_AGENT); }
__device__ __forceinline__ unsigned xb_xcc_id() { return (unsigned)__builtin_amdgcn_s_getreg((3 << 11) | 20) & 0xFu; }
#define XB_SPIN(cond, bar) do { unsigned _sp = 0; while (cond) { __builtin_amdgcn_s_sleep(1); \
    if ((++_sp & 255u) == 0u) { if (xb_ld(&(bar)[XB_TMO])) break; if (_sp > XB_SPIN_CAP) { atomicAdd(&(bar)[XB_TMO], 1u); break; } } } } while (0)
struct XcdBarrier { unsigned* bar; unsigned x; volatile LAS unsigned* st; };
__device__ __forceinline__ XcdBarrier xcd_barrier_post(unsigned* bar, volatile LAS unsigned* st) {
    XcdBarrier b; b.bar = bar; b.x = xb_xcc_id(); b.st = st;
    if (threadIdx.x == 0) (void)xb_add(&bar[XB_XCNT(b.x)], 1u);
    return b;
}
__device__ __forceinline__ void xcd_barrier_complete(unsigned* bar, unsigned x, unsigned& nloc, unsigned& nx) {
    const unsigned G = gridDim.x * gridDim.y * gridDim.z;
    unsigned sum, cnt, mine, sp = 0u;
    for (;;) {
        sum = 0u; cnt = 0u; mine = 0u;
#pragma unroll
        for (unsigned j = 0; j < 16; ++j) { const unsigned c = xb_ld(&bar[XB_XCNT(j)]); sum += c; cnt += (c > 0u) ? 1u : 0u; mine = (j == x) ? c : mine; }
        if (sum == G) break;
        __builtin_amdgcn_s_sleep(1);
        if ((++sp & 255u) == 0u) { if (xb_ld(&bar[XB_TMO])) break; if (sp > XB_SPIN_CAP) { atomicAdd(&bar[XB_TMO], 1u); break; } }
    }
    nloc = mine > 0u ? mine : 1u; nx = cnt > 0u ? cnt : 1u;
}
__device__ __forceinline__ void xcd_barrier(const XcdBarrier& b) {
    asm volatile("s_waitcnt vmcnt(0)" ::: "memory");
    __syncthreads();
    if (threadIdx.x == 0) {
        unsigned* bar = b.bar;
        __builtin_amdgcn_s_waitcnt(0);
        unsigned nloc = b.st[0], nx = b.st[1];
        if (nloc == 0u) { xcd_barrier_complete(bar, b.x, nloc, nx); b.st[0] = nloc; b.st[1] = nx; }
        const unsigned old = xb_add(&bar[XB_XSUB(b.x)], 1u);
        const unsigned gen = old / nloc;
        if (old + 1u == (gen + 1u) * nloc) {
            __builtin_amdgcn_fence(__ATOMIC_RELEASE, "agent");
            asm volatile("s_waitcnt vmcnt(0)" ::: "memory");
            const unsigned og = xb_add(&bar[XB_TOP], 1u);
            const unsigned tg = og / nx;
            if (og + 1u == (tg + 1u) * nx) xb_add(&bar[XB_TOPGEN], 1u);
            else XB_SPIN(xb_ld(&bar[XB_TOPGEN]) == tg, bar);
            __builtin_amdgcn_fence(__ATOMIC_ACQUIRE, "agent");
            xb_add(&bar[XB_XGEN(b.x)], 1u);
            asm volatile("s_waitcnt vmcnt(0)" ::: "memory");
        } else {
            XB_SPIN(xb_ld(&bar[XB_XGEN(b.x)]) == gen, bar);
            __builtin_amdgcn_fence(__ATOMIC_ACQUIRE, "agent");
            asm volatile("s_waitcnt vmcnt(0)" ::: "memory");
        }
    }
    __syncthreads();
}
constexpr int PPS = 8;
constexpr int NPHASE = 1 + NSEG * PPS + 1;
__global__ __launch_bounds__(512, 2) void mega(Params p) {
    extern __shared__ __attribute__((aligned(16))) unsigned char shm[];
    lds_t L = (lds_t)shm;
    cg::grid_group grid = cg::this_grid();
    volatile LAS unsigned* st = (volatile LAS unsigned*)(L + (LDS_BYTES - 16));
    if (threadIdx.x == 0) { st[0] = 0u; st[1] = 0u; }
    __syncthreads();
    const XcdBarrier xb = xcd_barrier_post((unsigned*)(p.ws + W_BAR), st);
    int redone = 0;
    for (int ph = p.ph_lo; ph < p.ph_hi; ++ph) {
        if (ph == 0) ph_wprep(p, L);
        else if (ph == NPHASE - 1) ph_ln<1>(p, NSEG - 1);
        else {
            const int s = (ph - 1) / PPS, k = (ph - 1) % PPS;
            const int mps = (s == 0) ? MP : MPR;
            if (k == 0 || k == 2) {
                if (k == 0 && s > 0) ph_ln<1>(p, s - 1);
                pg8::Gemm g; EpiB16<0> E;
                if (k == 0) { g.A = (const bf16_t*)(p.ws + W_XB) + xb_row0(s) * 1024; g.Bt = (const bf16_t*)(p.ws + W_WIN); g.M = mps; g.N = NPAD; g.K = 1024; g.lda = 1024; g.ldb = 1024; E.O = (bf16_t*)(p.ws + W_P); E.ldc = NPAD; E.hm = 0; }
                else { g.A = (const bf16_t*)(p.ws + W_LA); g.Bt = (const bf16_t*)(p.ws + W_WLORA); g.M = mps; g.N = 3072; g.K = 256; g.lda = 256; g.ldb = 256; E.O = (bf16_t*)(p.ws + W_L); E.ldc = 3072; E.hm = 1; }
                pg8::StaticOrder S; S.init(g.M, g.N, (int)gridDim.x, (int)blockIdx.x);
                pg8::gemm_phase<EpiB16<0>, pg8::StaticOrder, false>(L, g, S, E, nullptr);
                if (k == 2) { __syncthreads(); ph_gdnpre(p, L, s); }
            }
            else if (k == 1) ph_prep(p, s);
            else if (k == 3) ph_seq(p, L, s);
            else if (k == 4 || k == 7) {
                pg8::Gemm g; EpiAdd E; E.C = (float*)(p.ws + W_PL); E.xp = p.in[0]; E.xs = p.in[1]; E.s = s;
                if (k == 4) { g.A = (const bf16_t*)(p.ws + W_MG); g.Bt = (const bf16_t*)(p.ws + W_WOUT); g.M = MPR; g.N = 1024; g.K = 1024; g.lda = 1024; g.ldb = 1024; E.mode = 0; }
                else { g.A = (const bf16_t*)(p.ws + W_P); g.Bt = (const bf16_t*)(p.ws + W_WFF2); g.M = MPR; g.N = 1024; g.K = 4096; g.lda = LDF; g.ldb = LDF; E.mode = 1; }
                pg8::StaticOrder S; S.init(g.M, g.N, (int)gridDim.x, (int)blockIdx.x);
                pg8::gemm_phase<EpiAdd, pg8::StaticOrder, false>(L, g, S, E, nullptr);
                if (s == 0) { __syncthreads();
                    if (k == 4) skinny_gemm<0>(p, L, (const bf16_t*)(p.ws + W_MG) + (size_t)MPR * 1024, 1024, (const bf16_t*)(p.ws + W_WOUT), 1024, 1024, 1024);
                    else skinny_gemm<2>(p, L, (const bf16_t*)(p.ws + W_P) + (size_t)MPR * LDF, LDF, (const bf16_t*)(p.ws + W_WFF2), LDF, 1024, 4096); }
            }
            else if (k == 5) ph_ln<0>(p, s);
            else {
                pg8::Gemm g; EpiB16<1> E; g.A = (const bf16_t*)(p.ws + W_HB); g.Bt = (const bf16_t*)(p.ws + W_WFF1); g.M = MPR; g.N = 4096; g.K = 1024; g.lda = 1024; g.ldb = 1024; E.O = (bf16_t*)(p.ws + W_P); E.ldc = LDF; E.hm = 0;
                pg8::StaticOrder S; S.init(g.M, g.N, (int)gridDim.x, (int)blockIdx.x);
                pg8::gemm_phase<EpiB16<1>, pg8::StaticOrder, false>(L, g, S, E, nullptr);
                if (s == 0) { __syncthreads(); skinny_gemm<1>(p, L, (const bf16_t*)(p.ws + W_HB) + (size_t)MPR * 1024, 1024, (const bf16_t*)(p.ws + W_WFF1), 1024, 4096, 1024); }
            }
        }
        if (ph + 1 < p.ph_hi) { if (p.rep_mask == 0x7fffffff) grid.sync();   xcd_barrier(xb); }
        if ((p.rep_mask & 0x100000) && ph >= 1 && ph < NPHASE - 1 && ((ph - 1) % PPS) == 2 && !((redone >> ((ph - 1) / PPS)) & 1)) { redone |= 1 << ((ph - 1) / PPS); ph -= 3; }
    }
}

#ifndef REP_MASK
#define REP_MASK 0
#endif
extern "C" void kernel_launch(void* const* d_in, const int* in_sizes, int n_in, void* d_out, int out_size, void* d_ws, size_t ws_size, hipStream_t stream) {
    static int grid = 0;
    if (grid == 0) {
        int dev = 0, cus = 0, per_cu = 0;
        hipGetDevice(&dev);
        hipDeviceGetAttribute(&cus, hipDeviceAttributeMultiprocessorCount, dev);
        if (hipFuncSetAttribute((const void*)mega, hipFuncAttributeMaxDynamicSharedMemorySize, LDS_BYTES) != hipSuccess) { fprintf(stderr, "hipFuncSetAttribute failed\n"); }
        if (hipOccupancyMaxActiveBlocksPerMultiprocessor(&per_cu, (const void*)mega, 512, LDS_BYTES) != hipSuccess || per_cu < 1) { fprintf(stderr, "occupancy query: %d\n", per_cu); per_cu = 1; }
        (void)hipGetLastError();
        grid = cus * 1;
        if (ws_size < W_END) { fprintf(stderr, "workspace too small: %zu < %zu\n", ws_size, (size_t)W_END); grid = -1; }
    }
    if (grid < 0) return;
    (void)hipMemsetAsync((unsigned char*)d_ws + W_BAR, 0, 16384, stream);
    Params p{};
    for (int i = 0; i < 29; ++i) p.in[i] = (const float*)d_in[i];
    p.out = (float*)d_out; p.ws = (unsigned char*)d_ws; p.rep_mask = REP_MASK;
#if defined(MK_MULTI)
    for (int ph = 0; ph < NPHASE; ++ph) { p.ph_lo = ph; p.ph_hi = ph + 1; hipLaunchKernelGGL(mega, dim3(grid), dim3(512), LDS_BYTES, stream, p); }
#else
    p.ph_lo = 0; p.ph_hi = NPHASE;
    void* args[] = {&p};
    hipError_t e = hipLaunchCooperativeKernel((const void*)mega, dim3(grid), dim3(512), args, LDS_BYTES, stream);
    if (e != hipSuccess) fprintf(stderr, "cooperative launch failed: %s (grid %d)\n", hipGetErrorString(e), grid);
#endif
}
```

```cpp
#include <hip/hip_runtime.h>
#include <hip/hip_cooperative_groups.h>
#include <cstdio>
namespace cg = cooperative_groups;
namespace pg8 {
#define PG8_LAS __attribute__((address_space(3)))
typedef unsigned short bf16_t;
typedef short bf16x8 __attribute__((ext_vector_type(8)));
typedef float f32x4 __attribute__((ext_vector_type(4)));
typedef unsigned u32x4 __attribute__((ext_vector_type(4)));
constexpr int BM = 256, BK = 64, HALF = 128, HTB = HALF * BK * 2  , STAGE_BYTES = 8 * HTB, NXCD = 8, WGM = 8;

__host__ __device__ __forceinline__ int lds_byte(int r, int c) { const int st = (r >> 4) * 2 + (c >> 5), rr = r & 15, cc = c & 31, ob = rr * 64 + cc * 2; return st * 1024 + (ob ^ (((ob >> 9) & 1) << 5)); }
__host__ __device__ __forceinline__ void stage_rc(int b, int& R, int& C) { const int st = b / 1024, sb = b % 1024, swz = sb ^ (((sb >> 9) & 1) << 5); R = (st >> 1) * 16 + swz / 64; C = (st & 1) * 32 + (swz % 64) / 2; }
__host__ __device__ __forceinline__ int perm32(int rho) { const int n = rho >> 4, i = rho & 15; return 8 * (i >> 2) + 4 * n + (i & 3); }

struct Unit { int pm, pn; };
struct Gemm { const bf16_t* A; const bf16_t* Bt; int M, N, K; int lda, ldb; };

struct StaticOrder {
    int nM, nN, nwg, G, c;
    __host__ __device__ void init(int M, int N, int G_, int c_) { nM = M / BM; nN = N / BM; nwg = nM * nN; G = G_; c = c_; }
    __host__ __device__ bool next(int i, Unit& u) const {
        const long L = (long)i * G + c; if (L >= nwg) return false;
        int wgid = (int)L; { const int q = nwg / NXCD, r = nwg % NXCD, xcd = wgid % NXCD, off = wgid / NXCD; wgid = (xcd < r ? xcd * (q + 1) : r * (q + 1) + (xcd - r) * q) + off; }
        const int nig = WGM * nN, gid = wgid / nig, fm = gid * WGM, gsz = (nM - fm) < WGM ? (nM - fm) : WGM;
        u.pm = fm + ((wgid % nig) % gsz); u.pn = (wgid % nig) / gsz; return true;
    }
    __device__ __forceinline__ void a_ready(const Unit&) const {}
    __device__ __forceinline__ void done(const Unit&) const {}
};
typedef float f32x2c __attribute__((ext_vector_type(2)));
typedef __bf16 bf16v2c __attribute__((ext_vector_type(2)));
__device__ __forceinline__ unsigned cvt_pk_bf16(float lo, float hi) { f32x2c f = {lo, hi}; bf16v2c v = __builtin_convertvector(f, bf16v2c); return __builtin_bit_cast(unsigned, v); }
template <class Epi, class Sched, bool STAMP = false>
__device__ __forceinline__ void gemm_phase(PG8_LAS unsigned char* lds, const Gemm g, const Sched& S, const Epi& E, unsigned long long* stamps) {
    int tid_l = threadIdx.x; asm volatile("" : "+v"(tid_l)); const int tid = tid_l, wid = __builtin_amdgcn_readfirstlane(tid >> 6), lane = tid & 63, wr = wid >> 2, wc = wid & 3, fr = lane & 15, fq = lane >> 4;
    const int K = g.K, nt = K / BK;
    int ts_lo = 0, ts_hi = 0, nts = 0; const unsigned long long rt_entry = STAMP ? (unsigned long long)wall_clock64() : 0ull;
#define PG8_STAMP() do { if (STAMP && wid == 0 && nts < 64) { const unsigned long long _c = (unsigned long long)clock64(); \
        ts_lo = (lane == nts) ? (int)(unsigned)_c : ts_lo; ts_hi = (lane == nts) ? (int)(unsigned)(_c >> 32) : ts_hi; ++nts; } } while (0)
    PG8_STAMP();
    unsigned voffA[2], voffB[2];
#pragma unroll
    for (int i = 0; i < 2; ++i) { int R, C; stage_rc(tid * 16 + i * 8192, R, C); const int Rb = Epi::PERM ? ((R & ~31) + perm32(R & 31)) : R;
        voffA[i] = (unsigned)(R * g.lda + C) * 2u; voffB[i] = (unsigned)(Rb * g.ldb + C) * 2u; }
    const size_t kstep = (size_t)(BK * 2);
    const size_t hstepA = (size_t)HALF * g.lda * 2, hstepB = (size_t)HALF * g.ldb * 2;
    const size_t tstepA = 2 * hstepA, tstepB = 2 * hstepB;
    const unsigned ldsw = (unsigned)wid * 1024u;
    const int aoff = lds_byte(wr * 64 + fr, fq * 8), boff = lds_byte(wc * 32 + fr, fq * 8);
#define PG8_SA(b, h) (((b) * 2 + (h)) * HTB)
#define PG8_SB(b, h) ((4 + (b) * 2 + (h)) * HTB)
#define PG8_STAGE(bufoff, gbase, voff) do { _Pragma("unroll") for (int _i = 0; _i < 2; ++_i) \
        __builtin_amdgcn_global_load_lds((const unsigned*)((const char*)(gbase) + (voff)[_i]), (PG8_LAS unsigned*)(lds + (bufoff) + ldsw + _i * 8192), 16, 0, 0); } while (0)
#define PG8_LDA(dst, b, h) do { _Pragma("unroll") for (int m = 0; m < 4; ++m) _Pragma("unroll") for (int k = 0; k < 2; ++k) dst[m][k] = *(const PG8_LAS bf16x8*)(lds + PG8_SA(b, h) + aoff + m * 2048 + k * 1024); } while (0)
#define PG8_LDB(dst, b, h) do { _Pragma("unroll") for (int n = 0; n < 2; ++n) _Pragma("unroll") for (int k = 0; k < 2; ++k) dst[n][k] = *(const PG8_LAS bf16x8*)(lds + PG8_SB(b, h) + boff + n * 2048 + k * 1024); } while (0)
#define PG8_MMA(ai, bj, At, Bt) do { __builtin_amdgcn_s_setprio(1); _Pragma("unroll") for (int m = 0; m < 4; ++m) _Pragma("unroll") for (int n = 0; n < 2; ++n) _Pragma("unroll") for (int k = 0; k < 2; ++k) \
        acc[ai][bj][m][n] = __builtin_amdgcn_mfma_f32_16x16x32_bf16(Bt[n][k], At[m][k], acc[ai][bj][m][n], 0, 0, 0); __builtin_amdgcn_s_setprio(0); } while (0)
#define PG8_WAIT_V(n) asm volatile("s_waitcnt vmcnt(" #n ")" ::: "memory")
#define PG8_WAIT_L(n) asm volatile("s_waitcnt lgkmcnt(" #n ")" ::: "memory")
#define PG8_BAR __builtin_amdgcn_s_barrier()
#define PG8_SCHED __builtin_amdgcn_sched_barrier(0)
    Unit cur, nxt; int ui = 0;
    if (!S.next(0, cur)) return;
    f32x4 acc[2][2][4][2];
#pragma unroll
    for (int a = 0; a < 2; ++a)
#pragma unroll
        for (int b = 0; b < 2; ++b)
#pragma unroll
            for (int m = 0; m < 4; ++m)
#pragma unroll
                for (int n = 0; n < 2; ++n) acc[a][b][m][n] = (f32x4){0.f, 0.f, 0.f, 0.f};
    bf16x8 At[4][2], B0[2][2], B1[2][2];
    const char* cA = (const char*)g.A + (size_t)cur.pm * tstepA; const char* cB = (const char*)g.Bt + (size_t)cur.pn * tstepB;
    S.a_ready(cur);
    PG8_STAGE(PG8_SB(0, 0), cB, voffB); PG8_STAGE(PG8_SA(0, 0), cA, voffA); PG8_STAGE(PG8_SB(0, 1), cB + hstepB, voffB); PG8_STAGE(PG8_SA(0, 1), cA + hstepA, voffA);
    if (wr == 1) PG8_BAR;
    PG8_WAIT_V(4); PG8_BAR;
    PG8_STAGE(PG8_SB(1, 0), cB + kstep, voffB); PG8_STAGE(PG8_SA(1, 0), cA + kstep, voffA); PG8_STAGE(PG8_SB(1, 1), cB + hstepB + kstep, voffB);
    PG8_WAIT_V(6); PG8_BAR;
    PG8_STAMP();
    for (;;) {
        const bool has_next = S.next(ui + 1, nxt);
        const char* nA = has_next ? (const char*)g.A + (size_t)nxt.pm * tstepA : cA; const char* nB = has_next ? (const char*)g.Bt + (size_t)nxt.pn * tstepB : cB;
        for (int t = 0; t < nt; t += 2) {
            const bool last = (t == nt - 2);
            const char* a1 = cA + (size_t)(t + 1) * kstep;
            const char* a2 = last ? nA : cA + (size_t)(t + 2) * kstep; const char* b2 = last ? nB : cB + (size_t)(t + 2) * kstep;
            const char* a3 = a2 + kstep; const char* b3 = b2 + kstep;
            if (last && has_next) S.a_ready(nxt);
            PG8_LDB(B0, 0, 0); PG8_SCHED; PG8_LDA(At, 0, 0); PG8_STAGE(PG8_SA(1, 1), a1 + hstepA, voffA);
            PG8_WAIT_L(8); PG8_BAR; PG8_WAIT_L(0); PG8_MMA(0, 0, At, B0); PG8_BAR; PG8_SCHED;
            PG8_LDB(B1, 0, 1); PG8_STAGE(PG8_SB(0, 0), b2, voffB);
            PG8_BAR; PG8_WAIT_L(0); PG8_MMA(0, 1, At, B1); PG8_BAR;
            PG8_LDA(At, 0, 1); PG8_STAGE(PG8_SA(0, 0), a2, voffA);
            PG8_BAR; PG8_WAIT_L(0); PG8_MMA(1, 0, At, B0); PG8_BAR; PG8_SCHED;
            PG8_STAGE(PG8_SB(0, 1), b2 + hstepB, voffB);
            PG8_WAIT_V(6); PG8_BAR; PG8_MMA(1, 1, At, B1); PG8_BAR;
            PG8_LDB(B0, 1, 0); PG8_SCHED; PG8_LDA(At, 1, 0); PG8_STAGE(PG8_SA(0, 1), a2 + hstepA, voffA);
            PG8_WAIT_L(8); PG8_BAR; PG8_WAIT_L(0); PG8_MMA(0, 0, At, B0); PG8_BAR; PG8_SCHED;
            PG8_LDB(B1, 1, 1); PG8_STAGE(PG8_SB(1, 0), b3, voffB);
            PG8_BAR; PG8_WAIT_L(0); PG8_MMA(0, 1, At, B1); PG8_BAR;
            PG8_LDA(At, 1, 1); PG8_STAGE(PG8_SA(1, 0), a3, voffA);
            PG8_BAR; PG8_WAIT_L(0); PG8_MMA(1, 0, At, B0); PG8_BAR; PG8_SCHED;
            PG8_STAGE(PG8_SB(1, 1), b3 + hstepB, voffB);
            PG8_WAIT_V(6); PG8_BAR; PG8_MMA(1, 1, At, B1); PG8_BAR;
        }
        PG8_STAMP();
        if constexpr (!Epi::AFTER_DRAIN) { E(acc, cur, wr, wc, fr, fq); S.done(cur); }
        PG8_STAMP();
        if (!has_next) break;
#pragma unroll
        for (int a = 0; a < 2; ++a)
#pragma unroll
            for (int b = 0; b < 2; ++b)
#pragma unroll
                for (int m = 0; m < 4; ++m)
#pragma unroll
                    for (int n = 0; n < 2; ++n) acc[a][b][m][n] = (f32x4){0.f, 0.f, 0.f, 0.f};
        cur = nxt; cA = nA; cB = nB; ++ui;
    }
    PG8_WAIT_V(0);
    if (wr == 0) PG8_BAR;
    PG8_BAR;
    if constexpr (Epi::AFTER_DRAIN) { E.fused(acc, cur, wr, wc, fr, fq, lds, wid, lane); S.done(cur); }
    PG8_STAMP();
    if (STAMP && wid == 0) { stamps[lane] = lane < nts ? (((unsigned long long)(unsigned)ts_hi << 32) | (unsigned)ts_lo) : 0ull;
        if (lane == 62) stamps[62] = rt_entry; if (lane == 63) stamps[63] = (unsigned long long)wall_clock64(); }
#undef PG8_STAMP
#undef PG8_SA
#undef PG8_SB
#undef PG8_STAGE
#undef PG8_LDA
#undef PG8_LDB
#undef PG8_MMA
#undef PG8_WAIT_V
#undef PG8_WAIT_L
#undef PG8_BAR
#undef PG8_SCHED
}
}
using pg8::bf16_t; using pg8::bf16x8; using pg8::f32x4; using pg8::u32x4; using pg8::cvt_pk_bf16;
typedef float f32x2 __attribute__((ext_vector_type(2)));
typedef unsigned u32x2 __attribute__((ext_vector_type(2)));
#define LAS __attribute__((address_space(3)))
typedef LAS unsigned char* lds_t;

constexpr int D = 1024, NB = 32, SEQ = 2048, NSB = 8, NSS = 16;
constexpr int TS = 512, NSEG = SEQ / TS;
constexpr int MPR = NB * TS;
constexpr int MP = MPR + 256;
constexpr int NSAMP = NSB * NSS;
constexpr int NPAD = 9728, COLS = 9488;
constexpr int C_Z = 3072, C_BETA = 4096, C_AR = 4104, C_PB = 4112, C_GA = 7440, C_GB = 8464, CB = 3328;
constexpr float DN_ALPHA = 1.189207115002721f;
constexpr int LDS_BYTES = 163840;
constexpr int LDF = 4096 + 64;
constexpr int NITEM_P = NB * (TS / 64) * 8;
constexpr int NITEM = NITEM_P + 64;

constexpr size_t O_YP = 0, O_YS = O_YP + (size_t)NB * SEQ * D, O_CP = O_YS + (size_t)NSAMP * D, O_GP = O_CP + (size_t)NB * 3 * 3072,
    O_SP = O_GP + (size_t)NB * 8 * 16384, O_WP = O_SP + (size_t)NB * CB, O_CS = O_WP + (size_t)NB * 16 * 4096, O_GS = O_CS + (size_t)NSB * 3 * 3072,
    O_SS = O_GS + (size_t)NSB * 8 * 16384, O_WS = O_SS + (size_t)NSB * CB;
constexpr size_t al256(size_t x) { return (x + 255) & ~(size_t)255; }
constexpr size_t W_WIN = 0, W_WLORA = W_WIN + al256((size_t)NPAD * 1024 * 2), W_WOUT = W_WLORA + al256((size_t)3072 * 256 * 2), W_WFF1 = W_WOUT + al256((size_t)1024 * 1024 * 2),
    W_WFF2 = W_WFF1 + al256((size_t)4096 * 1024 * 2), W_XB = W_WFF2 + al256((size_t)LDF * 1024 * 2), W_P = W_XB + al256((size_t)(NSEG * MPR + 256) * 1024 * 2), W_QKV = W_P + al256((size_t)MP * NPAD * 2),
    W_BG = W_QKV + al256((size_t)MP * 3072 * 2), W_LA = W_BG + al256((size_t)MP * 16 * 4), W_L = W_LA + al256((size_t)MP * 256 * 2), W_T = W_L + al256((size_t)MP * 3072 * 2),
    W_GC = W_T + al256((size_t)NITEM * 8192 * 2), W_MG = W_GC + al256((size_t)NITEM * 64 * 4), W_PL = W_MG + al256((size_t)MP * 1024 * 2), W_CC = W_PL + al256((size_t)MP * 1024 * 4),
    W_SC = W_CC + al256((size_t)2 * NB * 3 * 3072 * 2), W_HB = W_SC + al256((size_t)2 * NB * CB * 2), W_BAR = W_HB + al256((size_t)MP * 1024 * 2), W_END = W_BAR + 16384;

struct Params { const float* in[29]; float* out; unsigned char* ws; int ph_lo, ph_hi; int rep_mask, pad0; };

__device__ __forceinline__ int ltid() { int t = threadIdx.x; asm volatile("" : "+v"(t)); return t; }
__device__ __forceinline__ float bf2f(unsigned v) { return __uint_as_float(v << 16); }
__device__ __forceinline__ float bflo(unsigned v) { return __uint_as_float(v << 16); }
__device__ __forceinline__ float bfhi(unsigned v) { return __uint_as_float(v & 0xffff0000u); }
__device__ __forceinline__ bf16_t f2bf(float f) { return (bf16_t)(cvt_pk_bf16(f, 0.f) & 0xffffu); }
__device__ __forceinline__ float sigm(float x) { return __builtin_amdgcn_rcpf(1.0f + __expf(-x)); }
__device__ __forceinline__ float tanh_fast(float x) { return 1.0f - 2.0f * __builtin_amdgcn_rcpf(1.0f + __expf(2.0f * x)); }
__device__ __forceinline__ float softplus_fast(float x) { return x > 20.f ? x : __logf(1.0f + __expf(x)); }
__device__ __forceinline__ float siluf(float x) { return x * sigm(x); }
__device__ __forceinline__ float softplusf(float x) { return x > 20.f ? x : log1pf(__expf(x)); }
template <int CTRL> __device__ __forceinline__ float dppmov(float v) { return __int_as_float(__builtin_amdgcn_update_dpp(0, __float_as_int(v), CTRL, 0xf, 0xf, true)); }
__device__ __forceinline__ float wave_sum(float v) {
    v += dppmov<0xB1>(v); v += dppmov<0x4E>(v); v += dppmov<0x141>(v); v += dppmov<0x140>(v);
    const int vi = __float_as_int(v);
    const float r0 = __int_as_float(__builtin_amdgcn_readlane(vi, 0)), r1 = __int_as_float(__builtin_amdgcn_readlane(vi, 16)), r2 = __int_as_float(__builtin_amdgcn_readlane(vi, 32)), r3 = __int_as_float(__builtin_amdgcn_readlane(vi, 48));
    return (r0 + r1) + (r2 + r3);
}
template <int N> struct IC { static constexpr int value = N; };
template <int N> __device__ __forceinline__ void wave_sumN(float (&v)[N]) {
#pragma unroll
    for (int q = 0; q < N; ++q) v[q] += dppmov<0xB1>(v[q]);
#pragma unroll
    for (int q = 0; q < N; ++q) v[q] += dppmov<0x4E>(v[q]);
#pragma unroll
    for (int q = 0; q < N; ++q) v[q] += dppmov<0x141>(v[q]);
#pragma unroll
    for (int q = 0; q < N; ++q) v[q] += dppmov<0x140>(v[q]);
    float r0[N], r1[N], r2[N], r3[N];
#pragma unroll
    for (int q = 0; q < N; ++q) { const int vi = __float_as_int(v[q]);
        r0[q] = __int_as_float(__builtin_amdgcn_readlane(vi, 0)); r1[q] = __int_as_float(__builtin_amdgcn_readlane(vi, 16)); r2[q] = __int_as_float(__builtin_amdgcn_readlane(vi, 32)); r3[q] = __int_as_float(__builtin_amdgcn_readlane(vi, 48)); }
#pragma unroll
    for (int q = 0; q < N; ++q) v[q] = (r0[q] + r1[q]) + (r2[q] + r3[q]);
}
__device__ __forceinline__ float reduce8(float v) { v += dppmov<0xB1>(v); v += dppmov<0x4E>(v); v += dppmov<0x141>(v); return v; }
__device__ __forceinline__ void lds_barrier() { asm volatile("s_waitcnt lgkmcnt(0)" ::: "memory"); __builtin_amdgcn_s_barrier(); asm volatile("" ::: "memory"); }
__device__ __forceinline__ f32x4 mfma16(bf16x8 a, bf16x8 b, f32x4 c) { return __builtin_amdgcn_mfma_f32_16x16x32_bf16(a, b, c, 0, 0, 0); }

__device__ __forceinline__ const float* xrow_ptr(const Params& p, int r, int s) {
    if (r < MPR) { const int b = r / TS, tt = r % TS; return p.in[0] + ((size_t)(b * SEQ + s * TS + tt)) * D; }
    if (s == 0 && r < MPR + NSAMP) return p.in[1] + (size_t)(r - MPR) * D;
    return nullptr;
}
__device__ __forceinline__ float* yrow_ptr(const Params& p, int r, int s) {
    if (r < MPR) { const int b = r / TS, tt = r % TS; return p.out + O_YP + ((size_t)(b * SEQ + s * TS + tt)) * D; }
    return p.out + O_YS + (size_t)(r - MPR) * D;
}

template <int ACT> struct EpiB16 {
    static constexpr bool PERM = true, AFTER_DRAIN = false;
    bf16_t* O; int ldc; int hm;
    __device__ __forceinline__ void operator()(const f32x4 (&acc)[2][2][4][2], const pg8::Unit& u, int wr, int wc, int fr, int fq) const {
        const int row0 = u.pm * 256 + wr * 64 + fr, col0 = u.pn * 256 + wc * 32 + 8 * fq;
        if (ACT == 0 && hm) {
#pragma unroll
            for (int ai = 0; ai < 2; ++ai)
#pragma unroll
                for (int m = 0; m < 4; ++m) { const int row = row0 + ai * 128 + m * 16;
                    size_t rbase_; int tlen, rr;
                    if (row < MPR) { rbase_ = 0; tlen = TS; rr = row; } else { rbase_ = (size_t)MPR * 3072; tlen = NSS; rr = row - MPR; }
                    const int bb = rr / tlen, t = rr % tlen;
#pragma unroll
                    for (int bj = 0; bj < 2; ++bj) { const int c8 = col0 + bj * 128, vec = c8 >> 10, head = (c8 & 1023) >> 6, ch = c8 & 63;
                        const size_t off = rbase_ + ((((size_t)(bb * 8 + (head >> 1)) * tlen + t) * 2 + (head & 1)) * 3 + vec) * 64 + ch;
                        const f32x4 v0 = acc[ai][bj][m][0], v1 = acc[ai][bj][m][1];
                        u32x4 w; w.x = cvt_pk_bf16(v0[0], v0[1]); w.y = cvt_pk_bf16(v0[2], v0[3]); w.z = cvt_pk_bf16(v1[0], v1[1]); w.w = cvt_pk_bf16(v1[2], v1[3]);
                        if (row < MPR + NSAMP) *(u32x4*)(O + off) = w; } }
            return;
        }
#pragma unroll
        for (int ai = 0; ai < 2; ++ai)
#pragma unroll
            for (int m = 0; m < 4; ++m) { bf16_t* rowp = O + (size_t)(row0 + ai * 128 + m * 16) * ldc + col0;
#pragma unroll
                for (int bj = 0; bj < 2; ++bj) { f32x4 v0 = acc[ai][bj][m][0], v1 = acc[ai][bj][m][1];
                    if (ACT == 1) {
#pragma unroll
                        for (int j = 0; j < 4; ++j) { const float a = fmaxf(v0[j], 0.f), b = fmaxf(v1[j], 0.f); v0[j] = a * a; v1[j] = b * b; } }
                    u32x4 w; w.x = cvt_pk_bf16(v0[0], v0[1]); w.y = cvt_pk_bf16(v0[2], v0[3]); w.z = cvt_pk_bf16(v1[0], v1[1]); w.w = cvt_pk_bf16(v1[2], v1[3]);
                    *(u32x4*)(rowp + bj * 128) = w; } }
    }
};
struct EpiAdd {
    static constexpr bool PERM = false, AFTER_DRAIN = false;
    float* C; const float* xp; const float* xs; int s; int mode;
    __device__ __forceinline__ void operator()(const f32x4 (&acc)[2][2][4][2], const pg8::Unit& u, int wr, int wc, int fr, int fq) const {
        const int row0 = u.pm * 256 + wr * 64 + fr, col0 = u.pn * 256 + wc * 32 + 4 * fq;
#pragma unroll
        for (int ai = 0; ai < 2; ++ai)
#pragma unroll
            for (int m = 0; m < 4; ++m) { const int row = row0 + ai * 128 + m * 16; float* rowp = C + (size_t)row * 1024 + col0;
                const float* bp;
                if (mode) bp = rowp;
                else { if (row < MPR) { const int b = row / TS, tt = row % TS; bp = xp + ((size_t)(b * SEQ + s * TS + tt)) * D + col0; }
                       else if (s == 0 && row < MPR + NSAMP) bp = xs + (size_t)(row - MPR) * D + col0; else bp = nullptr; }
#pragma unroll
                for (int bj = 0; bj < 2; ++bj)
#pragma unroll
                    for (int n = 0; n < 2; ++n) { f32x4 bs = (f32x4){0.f, 0.f, 0.f, 0.f}; if (bp) bs = *(const f32x4*)(bp + bj * 128 + n * 16);
                        *(f32x4*)(rowp + bj * 128 + n * 16) = acc[ai][bj][m][n] + DN_ALPHA * bs; }
                asm volatile("" ::: "memory"); }
    }
};
__device__ __forceinline__ size_t xb_row0(int s);
__device__ __forceinline__ void ph_wprep(const Params& p, lds_t L) {
    LAS float* tile = (LAS float*)L;
    const int tid = ltid();
    bf16_t* xb = (bf16_t*)(p.ws + W_XB);
    const int cc = (tid & 127) * 8, G = gridDim.x, nr4 = (NSEG * MPR + 256) / 4;
    for (int i = 0; ; ++i) {
        const int it = blockIdx.x + i * G, cbase = blockIdx.x + i * 4 * G;
        const bool hasW = it < 4736, hasC = cbase < nr4;
        if (!hasW && !hasC) break;
        f32x4 ca[4], cb[4];
        if (hasC) {
#pragma unroll
            for (int u = 0; u < 4; ++u) { const int r4 = cbase + u * G; ca[u] = (f32x4){0.f, 0.f, 0.f, 0.f}; cb[u] = ca[u];
                if (r4 < nr4) { const int ra = r4 * 4 + (tid >> 7); const float* src;
                    if (ra < MP) src = xrow_ptr(p, ra, 0); else { const int q = ra - MP; src = xrow_ptr(p, q % MPR, 1 + q / MPR); }
                    if (src) { ca[u] = *(const f32x4*)(src + cc); cb[u] = *(const f32x4*)(src + cc + 4); } } }
        }
        if (hasW) {
            const float* W; bf16_t* WT; int K, N, NP_; int r = it; int ldw = 0;
            if (r < 2432) { W = p.in[6]; WT = (bf16_t*)(p.ws + W_WIN); K = 1024; N = COLS; NP_ = NPAD; }
            else if ((r -= 2432) < 256) { W = p.in[22]; WT = (bf16_t*)(p.ws + W_WOUT); K = 1024; N = 1024; NP_ = 1024; }
            else if ((r -= 256) < 1024) { W = p.in[25]; WT = (bf16_t*)(p.ws + W_WFF1); K = 1024; N = 4096; NP_ = 4096; }
            else { r -= 1024; W = p.in[26]; WT = (bf16_t*)(p.ws + W_WFF2); K = 4096; N = 1024; NP_ = 1024; ldw = LDF; }
            if (ldw == 0) ldw = K;
            const int ntl = NP_ / 64, k0 = (r / ntl) * 64, n0 = (r % ntl) * 64;
            { const int j = tid & 63, i0 = tid >> 6;
#pragma unroll
              for (int q = 0; q < 8; ++q) { const int ii = i0 + 8 * q; tile[ii * 65 + j] = (n0 + j < N) ? W[(size_t)(k0 + ii) * N + n0 + j] : 0.f; } }
            __syncthreads();
            { const int k2 = (tid & 31) * 2, nn = tid >> 5;
#pragma unroll
              for (int q = 0; q < 4; ++q) { const int n = nn + 16 * q; *(unsigned*)(WT + (size_t)(n0 + n) * ldw + k0 + k2) = cvt_pk_bf16(tile[k2 * 65 + n], tile[(k2 + 1) * 65 + n]); } }
            __syncthreads();
        }
        if (hasC) {
#pragma unroll
            for (int u = 0; u < 4; ++u) { const int r4 = cbase + u * G;
                if (r4 < nr4) { u32x4 o; o.x = cvt_pk_bf16(ca[u][0], ca[u][1]); o.y = cvt_pk_bf16(ca[u][2], ca[u][3]); o.z = cvt_pk_bf16(cb[u][0], cb[u][1]); o.w = cvt_pk_bf16(cb[u][2], cb[u][3]);
                    *(u32x4*)(xb + (size_t)(r4 * 4 + (tid >> 7)) * 1024 + cc) = o; } }
        }
    }
    bf16_t* WL = (bf16_t*)(p.ws + W_WLORA);
    for (int idx = blockIdx.x * 512 + tid; idx < 3072 * 256; idx += gridDim.x * 512) {
        const int n = idx >> 8, k = idx & 255; float v = 0.f;
        if (n < 1024) { if (k < 64) v = p.in[13][k * 1024 + n]; }
        else if (n < 2048) { if (k >= 64 && k < 128) v = p.in[15][(k - 64) * 1024 + n - 1024]; }
        else { if (k >= 128) v = p.in[16][(k - 128) * 1024 + n - 2048]; }
        WL[idx] = f2bf(v);
    }
}
__device__ __forceinline__ size_t xb_row0(int s) { return (size_t)s * MPR + (s > 0 ? 256 : 0); }
__device__ __forceinline__ void ph_cvt_all(const Params& p) {
    bf16_t* xb = (bf16_t*)(p.ws + W_XB);
    const int tid = ltid();
    const int c = (tid & 127) * 8, G = gridDim.x, nr4 = (NSEG * MPR + 256) / 4;
    for (int base = blockIdx.x; base < nr4; base += 4 * G) {
        f32x4 a[4], b[4];
#pragma unroll
        for (int u = 0; u < 4; ++u) { const int r4 = base + u * G; a[u] = (f32x4){0.f, 0.f, 0.f, 0.f}; b[u] = a[u];
            if (r4 < nr4) { const int ra = r4 * 4 + (tid >> 7); const float* src;
                if (ra < MP) src = xrow_ptr(p, ra, 0); else { const int q = ra - MP; src = xrow_ptr(p, q % MPR, 1 + q / MPR); }
                if (src) { a[u] = *(const f32x4*)(src + c); b[u] = *(const f32x4*)(src + c + 4); } } }
#pragma unroll
        for (int u = 0; u < 4; ++u) { const int r4 = base + u * G;
            if (r4 < nr4) { u32x4 o; o.x = cvt_pk_bf16(a[u][0], a[u][1]); o.y = cvt_pk_bf16(a[u][2], a[u][3]); o.z = cvt_pk_bf16(b[u][0], b[u][1]); o.w = cvt_pk_bf16(b[u][2], b[u][3]);
                *(u32x4*)(xb + (size_t)(r4 * 4 + (tid >> 7)) * 1024 + c) = o; } }
    }
}
__device__ __forceinline__ void ph_prep(const Params& p, int s) {
    const bf16_t* P = (const bf16_t*)(p.ws + W_P);
    bf16_t* QKV = (bf16_t*)(p.ws + W_QKV); float* BG = (float*)(p.ws + W_BG); bf16_t* LA = (bf16_t*)(p.ws + W_LA);
    bf16_t* CC = (bf16_t*)(p.ws + W_CC); bf16_t* SC = (bf16_t*)(p.ws + W_SC);
    const int tid = ltid();
    constexpr int GR = 16;
    const int ngr = ((s == 0) ? (MPR + NSAMP) : MPR) / GR;
    const float* cw = p.in[7];
    for (int g = blockIdx.x; g < ngr; g += gridDim.x) {
        const int r0 = g * GR; const bool samp = r0 >= MPR;
        const int b = samp ? (r0 - MPR) / NSS : r0 / TS, tt0 = samp ? (r0 - MPR) % NSS : r0 % TS, tlen = samp ? NSS : TS;
        const bool lastg = (tt0 == tlen - GR);
        unsigned raw[3][GR + 3]; float xf0[3][3], xf1[3][3];
        const int cmode = (tt0 > 0) ? 0 : (samp ? 1 : (s > 0 ? 2 : 3));
#pragma unroll
        for (int sec = 0; sec < 3; ++sec) { const int ch = sec * 1024 + 2 * tid;
#pragma unroll
            for (int q = 0; q < GR + 3; ++q) {
                if (q >= 3 || cmode == 0) raw[sec][q] = *(const unsigned*)(P + (size_t)(r0 - 3 + q) * NPAD + ch);
                else if (cmode == 2) raw[sec][q] = *(const unsigned*)(CC + ((size_t)((s & 1) * NB + b) * 3 + q) * 3072 + ch);
                else raw[sec][q] = 0u;
                if (q < 3) { xf0[sec][q] = 0.f; xf1[sec][q] = 0.f; if (cmode == 1) { const float* sp = p.in[2] + ((size_t)(b * 3 + q)) * 3072 + ch; xf0[sec][q] = sp[0]; xf1[sec][q] = sp[1]; } }
            } }
        float lpv[GR / 2], lprev[GR / 2];
#pragma unroll
        for (int e = 0; e < GR / 2; ++e) { const int item = tid + 512 * e, j = item >> 8, c = item & 255, col = 3072 + c;
            lpv[e] = bf2f(P[(size_t)(r0 + j) * NPAD + C_PB + col]);
            if (tt0 + j > 0) lprev[e] = bf2f(P[(size_t)(r0 + j - 1) * NPAD + C_PB + col]);
            else if (samp) lprev[e] = p.in[4][(size_t)b * CB + col];
            else if (s > 0) lprev[e] = bf2f(SC[((size_t)((s & 1) * NB + b)) * CB + col]);
            else lprev[e] = 0.f; }
#pragma unroll
        for (int sec = 0; sec < 3; ++sec) {
            const int ch = sec * 1024 + 2 * tid;
            float x0[GR + 3], x1[GR + 3];
#pragma unroll
            for (int q = 0; q < GR + 3; ++q) { x0[q] = bflo(raw[sec][q]); x1[q] = bfhi(raw[sec][q]); if (q < 3 && cmode == 1) { x0[q] = xf0[sec][q]; x1[q] = xf1[sec][q]; } }
            float w0[4], w1[4];
#pragma unroll
            for (int j = 0; j < 4; ++j) { w0[j] = cw[j * 3072 + ch]; w1[j] = cw[j * 3072 + ch + 1]; }
#pragma unroll
            for (int j = 0; j < GR; ++j) {
                float y0 = 0.f, y1 = 0.f;
#pragma unroll
                for (int t = 0; t < 4; ++t) { y0 += w0[t] * x0[j + t]; y1 += w1[t] * x1[j + t]; }
                y0 = siluf(y0); y1 = siluf(y1);
                if (sec < 2) { const float ss = wave_sum(y0 * y0 + y1 * y1); float rn = rsqrtf(ss + 1e-6f); if (sec == 0) rn *= 0.08838834764831845f; y0 *= rn; y1 *= rn; }
                *(unsigned*)(QKV + (size_t)(r0 + j) * 3072 + ch) = cvt_pk_bf16(y0, y1);
            }
            if (lastg) {
#pragma unroll
                for (int j = GR - 3; j < GR; ++j) { const int ci = j - (GR - 3);
                    if (!samp) { *(unsigned*)(CC + ((size_t)(((s + 1) & 1) * NB + b) * 3 + ci) * 3072 + ch) = raw[sec][j + 3];
                        if (s == NSEG - 1) { float* o = p.out + O_CP + ((size_t)(b * 3 + ci)) * 3072 + ch; o[0] = x0[j + 3]; o[1] = x1[j + 3]; } }
                    else { float* o = p.out + O_CS + ((size_t)(b * 3 + ci)) * 3072 + ch; o[0] = x0[j + 3]; o[1] = x1[j + 3]; }
                }
            }
        }
        if (tid < GR * 8) { const int j = tid >> 3, h = tid & 7; const bf16_t* Pr = P + (size_t)(r0 + j) * NPAD;
            const float br = bf2f(Pr[C_BETA + h]), ar = bf2f(Pr[C_AR + h]);
            BG[(size_t)(r0 + j) * 16 + h] = sigm(br); BG[(size_t)(r0 + j) * 16 + 8 + h] = -__expf(p.in[8][h]) * softplusf(ar + p.in[9][h]); }
#pragma unroll
        for (int e = 0; e < GR / 2; ++e) { const int item = tid + 512 * e, j = item >> 8, c = item & 255, col = 3072 + c;
            const float pv = lpv[e], prev = lprev[e];
            const float xs = pv + p.in[11][col] * (prev - pv);
            const float v = (c < 64) ? tanh_fast(xs) : ((c < 128) ? xs : sigm(xs));
            LA[(size_t)(r0 + j) * 256 + c] = f2bf(v); }
        if (lastg) { const bf16_t* Pr = P + (size_t)(r0 + GR - 1) * NPAD + C_PB;
            for (int c = tid; c < CB; c += 512) { const bf16_t v = Pr[c];
                if (!samp) { SC[((size_t)(((s + 1) & 1) * NB + b)) * CB + c] = v; if (s == NSEG - 1) p.out[O_SP + (size_t)b * CB + c] = bf2f(v); }
                else p.out[O_SS + (size_t)b * CB + c] = bf2f(v); } }
    }
}
template <int WHICH> __device__ __forceinline__ void ph_ln(const Params& p, int s) {
    float* PL = (float*)(p.ws + W_PL); bf16_t* hb = (bf16_t*)(p.ws + W_HB);
    const int tidl = ltid(); const int lane = tidl & 63, wave = tidl >> 6, nv = (s == 0) ? (MPR + NSAMP) : MPR;
    const float* gg = p.in[WHICH == 0 ? 23 : 27]; const float* bb = p.in[WHICH == 0 ? 24 : 28];
    f32x4 gv[4], bv[4];
#pragma unroll
    for (int j = 0; j < 4; ++j) { gv[j] = *(const f32x4*)(gg + (lane + 64 * j) * 4); bv[j] = *(const f32x4*)(bb + (lane + 64 * j) * 4); }
    const int stride = gridDim.x * 8;
    int r = blockIdx.x * 8 + wave;
    f32x4 v[4];
    if (r < nv) {
#pragma unroll
        for (int j = 0; j < 4; ++j) v[j] = *(const f32x4*)(PL + (size_t)r * 1024 + (lane + 64 * j) * 4); }
    for (; r < nv; r += stride) {
        float* xr = PL + (size_t)r * 1024;
        f32x4 vn[4];
#pragma unroll
        for (int j = 0; j < 4; ++j) vn[j] = v[j];
        if (r + stride < nv) {
#pragma unroll
            for (int j = 0; j < 4; ++j) vn[j] = *(const f32x4*)(PL + (size_t)(r + stride) * 1024 + (lane + 64 * j) * 4); }
        float sm = 0.f;
#pragma unroll
        for (int j = 0; j < 4; ++j) sm += (v[j][0] + v[j][1]) + (v[j][2] + v[j][3]);
        const float mean = wave_sum(sm) * (1.f / 1024.f); float s2 = 0.f;
#pragma unroll
        for (int j = 0; j < 4; ++j) { v[j] = v[j] - mean; s2 += (v[j][0] * v[j][0] + v[j][1] * v[j][1]) + (v[j][2] * v[j][2] + v[j][3] * v[j][3]); }
        const float rstd = rsqrtf(wave_sum(s2) * (1.f / 1024.f) + 1e-5f);
        float* yo = (WHICH == 0) ? xr : yrow_ptr(p, r, s);
#pragma unroll
        for (int j = 0; j < 4; ++j) { const f32x4 o = v[j] * rstd * gv[j] + bv[j]; *(f32x4*)(yo + (lane + 64 * j) * 4) = o;
            if (WHICH == 0) { u32x2 w; w.x = cvt_pk_bf16(o[0], o[1]); w.y = cvt_pk_bf16(o[2], o[3]); *(u32x2*)(hb + (size_t)r * 1024 + (lane + 64 * j) * 4) = w; } }
#pragma unroll
        for (int j = 0; j < 4; ++j) v[j] = vn[j];
    }
}
__device__ __forceinline__ void ph_gdnpre(const Params& p, lds_t L, int s) {
    const bf16_t* QKV = (const bf16_t*)(p.ws + W_QKV); const float* BG = (const float*)(p.ws + W_BG);
    bf16_t* Tm = (bf16_t*)(p.ws + W_T); float* GC = (float*)(p.ws + W_GC);
    const int tidl = ltid(); const int lane = tidl & 63, wave = tidl >> 6, l15 = lane & 15, lq = lane >> 4;
    LAS float* Af = (LAS float*)(L + wave * 16896); LAS float* gcs = Af + 4096; LAS float* bts = gcs + 64;
    const int ni = (s == 0) ? NITEM : NITEM_P;
    for (int it = blockIdx.x * 8 + wave; it < ni; it += gridDim.x * 8) {
        int row0, h, nvalid;
        if (it < NITEM_P) { const int b = it >> 6, ck = (it >> 3) & 7; h = it & 7; row0 = b * TS + ck * 64; nvalid = 64; }
        else { const int j = it - NITEM_P; h = j & 7; row0 = MPR + (j >> 3) * NSS; nvalid = NSS; }
        float g = 0.f, bt = 0.f;
        if (lane < nvalid) { g = BG[(size_t)(row0 + lane) * 16 + 8 + h]; bt = BG[(size_t)(row0 + lane) * 16 + h]; }
#pragma unroll
        for (int o = 1; o < 64; o <<= 1) { const float t = __shfl_up(g, o); if (lane >= o) g += t; }
        gcs[lane] = g; bts[lane] = bt;
        f32x4 acc[4][4];
#pragma unroll
        for (int I = 0; I < 4; ++I)
#pragma unroll
            for (int J = 0; J < 4; ++J) acc[I][J] = (f32x4){0.f, 0.f, 0.f, 0.f};
#pragma unroll
        for (int kk = 0; kk < 4; ++kk) {
            bf16x8 fr[4];
#pragma unroll
            for (int I = 0; I < 4; ++I) { const int row = 16 * I + l15; u32x4 v = (u32x4){0u, 0u, 0u, 0u};
                if (row < nvalid) v = *(const u32x4*)(QKV + (size_t)(row0 + row) * 3072 + 1024 + h * 128 + kk * 32 + 8 * lq);
                fr[I] = __builtin_bit_cast(bf16x8, v); }
#pragma unroll
            for (int I = 0; I < 4; ++I)
#pragma unroll
                for (int J = 0; J <= I; ++J) acc[I][J] = mfma16(fr[I], fr[J], acc[I][J]);
            asm volatile("" ::: "memory");
        }
        asm volatile("s_waitcnt lgkmcnt(0)" ::: "memory");
#pragma unroll
        for (int I = 0; I < 4; ++I)
#pragma unroll
            for (int J = 0; J < 4; ++J)
#pragma unroll
                for (int jj = 0; jj < 4; ++jj) { const int i = 16 * I + 4 * lq + jj, j = 16 * J + l15;
                    float val = 0.f; if (J <= I && i > j) val = bts[i] * acc[I][J][jj] * __expf(gcs[i] - gcs[j]);
                    Af[i * 64 + j] = val; }
        asm volatile("s_waitcnt lgkmcnt(0)" ::: "memory");
        float t[64];
        int ll = lane; asm volatile("" : "+v"(ll));
#pragma unroll
        for (int i = 0; i < 64; ++i) {
            float a0 = (ll == i) ? 1.f : 0.f, a1 = 0.f;
#pragma unroll
            for (int j4 = 0; j4 < i; j4 += 4) { const f32x4 av = *(const LAS f32x4*)(Af + i * 64 + j4);
                a0 -= av[0] * t[j4]; if (j4 + 1 < i) a1 -= av[1] * t[j4 + 1]; if (j4 + 2 < i) a0 -= av[2] * t[j4 + 2]; if (j4 + 3 < i) a1 -= av[3] * t[j4 + 3]; }
            t[i] = a0 + a1;
            asm volatile("" ::: "memory");
        }
        const float sb = bts[lane], sg = sb * __expf(gcs[lane]);
        const float gcl = gcs[lane];
        asm volatile("s_waitcnt lgkmcnt(0)" ::: "memory");
        LAS bf16_t* TL = (LAS bf16_t*)Af;
#pragma unroll
        for (int i = 0; i < 64; ++i) { TL[i * 64 + lane] = f2bf(t[i] * sb); TL[4096 + i * 64 + lane] = f2bf(t[i] * sg); if ((i & 3) == 3) asm volatile("" ::: "memory"); }
        asm volatile("s_waitcnt lgkmcnt(0)" ::: "memory");
        bf16_t* Tb = Tm + (size_t)it * 8192;
#pragma unroll
        for (int q = 0; q < 16; ++q) *(u32x4*)(Tb + (size_t)(lane + 64 * q) * 8) = *(const LAS u32x4*)(TL + (lane + 64 * q) * 8);
        GC[(size_t)it * 64 + lane] = gcl;
        asm volatile("s_waitcnt lgkmcnt(0)" ::: "memory");
    }
}

constexpr int G_QH = 0, G_KH = 17408, G_KT = 34816, G_VT = 53248, G_VS = 71680, G_TB = 90112, G_TG = 99328, G_QK = 108544, G_SB = 117760, G_SM = 152576;
__device__ __forceinline__ int tofs(int r, int c) { return (r * 72 + c) * 2; }
#define LFRAG(off) (*(const LAS bf16x8*)(L + (off)))
__device__ __forceinline__ void gdn_seq(const Params& p, lds_t L, int row0, int nchunks, int nvalid, int item0, int h, const float* Sin, float* Sout) {
    const bf16_t* P = (const bf16_t*)(p.ws + W_P); const bf16_t* QKV = (const bf16_t*)(p.ws + W_QKV);
    const bf16_t* Tm = (const bf16_t*)(p.ws + W_T); const float* GC = (const float*)(p.ws + W_GC); bf16_t* MG = (bf16_t*)(p.ws + W_MG);
    const int tid = ltid(), lane = tid & 63, wave = tid >> 6, l15 = lane & 15, lq = lane >> 4;
    LAS float* SM = (LAS float*)(L + G_SM);
    f32x4 accS[8];
#pragma unroll
    for (int kt = 0; kt < 8; ++kt) { accS[kt] = (f32x4){0.f, 0.f, 0.f, 0.f}; if (Sin) accS[kt] = *(const f32x4*)(Sin + (size_t)(16 * kt + l15) * 128 + 16 * wave + 4 * lq); }
    const float ng0 = p.in[10][2 * lane], ng1 = p.in[10][2 * lane + 1];
    u32x4 pq[2], pk[2], pv[2], ptb, ptg; float pgc, pgl;
    auto gload = [&](int c) {
        const int r0n = row0 + c * 64, itn = item0 + c * 8;
        int tl2 = tid; asm volatile("" : "+v"(tl2));
        const int ln = tl2 & 63, wv = tl2 >> 6;
#pragma unroll
        for (int e = 0; e < 2; ++e) { const int c8 = (wv * 2 + e) * 8;
            pq[e] = (u32x4){0u, 0u, 0u, 0u}; pk[e] = pq[e]; pv[e] = pq[e];
            if (ln < nvalid) { const bf16_t* src = QKV + (size_t)(r0n + ln) * 3072 + h * 128 + c8; pq[e] = *(const u32x4*)src; pk[e] = *(const u32x4*)(src + 1024); pv[e] = *(const u32x4*)(src + 2048); } }
        { const int row = tl2 >> 3, c8 = (tl2 & 7) * 8; const bf16_t* src = Tm + (size_t)itn * 8192 + row * 64 + c8; ptb = *(const u32x4*)src; ptg = *(const u32x4*)(src + 4096); }
        pgc = GC[(size_t)itn * 64 + ln]; pgl = GC[(size_t)itn * 64 + 63];
    };
    gload(0);
    for (int ck = 0; ck < nchunks; ++ck) {
        const int r0 = row0 + ck * 64, item = item0 + ck * 8;
        int tl_ = tid; asm volatile("" : "+v"(tl_));
        const int lane = tl_ & 63, wave = tl_ >> 6, l15 = lane & 15, lq = lane >> 4;
#pragma unroll
        for (int e = 0; e < 2; ++e) {
            const int row = lane, c8 = (wave * 2 + e) * 8;
            const u32x4 q = pq[e], k = pk[e], v = pv[e];
            *(LAS u32x4*)(L + G_QH + (row * 136 + c8) * 2) = q;
            *(LAS u32x4*)(L + G_KH + (row * 136 + c8) * 2) = k;
#pragma unroll
            for (int x = 0; x < 4; ++x) {
                *(LAS bf16_t*)(L + G_KT + tofs(c8 + 2 * x, row)) = (bf16_t)(k[x] & 0xffffu); *(LAS bf16_t*)(L + G_KT + tofs(c8 + 2 * x + 1, row)) = (bf16_t)(k[x] >> 16);
                *(LAS bf16_t*)(L + G_VT + tofs(c8 + 2 * x, row)) = (bf16_t)(v[x] & 0xffffu); *(LAS bf16_t*)(L + G_VT + tofs(c8 + 2 * x + 1, row)) = (bf16_t)(v[x] >> 16);
            }
        }
        { const int row = tid >> 3, c8 = (tid & 7) * 8;
          *(LAS u32x4*)(L + G_TB + (row * 72 + c8) * 2) = ptb; *(LAS u32x4*)(L + G_TG + (row * 72 + c8) * 2) = ptg; }
        if (tid < 64) { const float gcv = pgc, gl = pgl;
            SM[tid] = gcv; SM[64 + tid] = __expf(gcv); SM[128 + tid] = __expf(gl - gcv); if (tid == 0) SM[192] = __expf(gl); }
        if (ck + 1 < nchunks) gload(ck + 1);
        if (ck == 0) {
#pragma unroll
            for (int kt = 0; kt < 8; ++kt)
#pragma unroll
                for (int jj = 0; jj < 4; ++jj) *(LAS bf16_t*)(L + G_SB + ((16 * wave + 4 * lq + jj) * 136 + 16 * kt + l15) * 2) = f2bf(accS[kt][jj]);
        }
        lds_barrier();
        {
            const int tI = wave >> 1;
#pragma unroll
            for (int x = 0; x < 2; ++x) { const int tJ = 2 * (wave & 1) + x; f32x4 a = (f32x4){0.f, 0.f, 0.f, 0.f};
                if (tJ <= tI) {
#pragma unroll
                    for (int kk = 0; kk < 4; ++kk) a = mfma16(LFRAG(G_QH + ((16 * tI + l15) * 136 + kk * 32 + 8 * lq) * 2), LFRAG(G_KH + ((16 * tJ + l15) * 136 + kk * 32 + 8 * lq) * 2), a); }
#pragma unroll
                for (int jj = 0; jj < 4; ++jj) { const int i = 16 * tI + 4 * lq + jj, j = 16 * tJ + l15;
                    const float val = (i >= j) ? a[jj] * __expf(SM[i] - SM[j]) : 0.f;
                    *(LAS bf16_t*)(L + G_QK + (i * 72 + j) * 2) = f2bf(val); } }
        }
        f32x4 accU[4], accW[4];
#pragma unroll
        for (int ct = 0; ct < 4; ++ct) { accU[ct] = (f32x4){0.f, 0.f, 0.f, 0.f}; accW[ct] = accU[ct];
#pragma unroll
            for (int js = 0; js < 2; ++js) {
                accU[ct] = mfma16(LFRAG(G_VT + tofs(16 * wave + l15, js * 32 + 8 * lq)), LFRAG(G_TB + ((16 * ct + l15) * 72 + js * 32 + 8 * lq) * 2), accU[ct]);
                accW[ct] = mfma16(LFRAG(G_TG + ((16 * ct + l15) * 72 + js * 32 + 8 * lq) * 2), LFRAG(G_KT + tofs(16 * wave + l15, js * 32 + 8 * lq)), accW[ct]); }
            asm volatile("" ::: "memory"); }
        lds_barrier();
#pragma unroll
        for (int ct = 0; ct < 4; ++ct)
#pragma unroll
            for (int jj = 0; jj < 4; ++jj) *(LAS bf16_t*)(L + G_KH + ((16 * ct + 4 * lq + jj) * 136 + 16 * wave + l15) * 2) = f2bf(-accW[ct][jj]);
        lds_barrier();
        unsigned zz8[8], ga8[8];
#pragma unroll
        for (int q = 0; q < 8; ++q) { const int c = wave + 8 * q; zz8[q] = 0u; ga8[q] = 0u;
            if (c < nvalid) { const size_t row = (size_t)(r0 + c); const int col = h * 128 + 2 * lane; zz8[q] = *(const unsigned*)(P + row * NPAD + C_Z + col); ga8[q] = *(const unsigned*)(P + row * NPAD + C_GA + col); } }
        f32x4 accO[4];
        {
            bf16x8 sf[4];
#pragma unroll
            for (int ks = 0; ks < 4; ++ks) sf[ks] = LFRAG(G_SB + ((16 * wave + l15) * 136 + ks * 32 + 8 * lq) * 2);
#pragma unroll
            for (int ct = 0; ct < 4; ++ct) { accO[ct] = (f32x4){0.f, 0.f, 0.f, 0.f};
#pragma unroll
                for (int ks = 0; ks < 4; ++ks) {
                    accU[ct] = mfma16(sf[ks], LFRAG(G_KH + ((16 * ct + l15) * 136 + ks * 32 + 8 * lq) * 2), accU[ct]);
                    accO[ct] = mfma16(sf[ks], LFRAG(G_QH + ((16 * ct + l15) * 136 + ks * 32 + 8 * lq) * 2), accO[ct]); }
                const int c = 16 * ct + l15; const float ec = SM[128 + c], eg = SM[64 + c];
#pragma unroll
                for (int jj = 0; jj < 4; ++jj) { const int v = 16 * wave + 4 * lq + jj;
                    *(LAS bf16_t*)(L + G_VT + tofs(v, c)) = f2bf(accU[ct][jj]); *(LAS bf16_t*)(L + G_VS + tofs(v, c)) = f2bf(accU[ct][jj] * ec);
                    accO[ct][jj] *= eg; }
                asm volatile("" ::: "memory"); }
        }
        lds_barrier();
        {
            bf16x8 vf[2], vsf[2];
#pragma unroll
            for (int js = 0; js < 2; ++js) { vf[js] = LFRAG(G_VT + tofs(16 * wave + l15, js * 32 + 8 * lq)); vsf[js] = LFRAG(G_VS + tofs(16 * wave + l15, js * 32 + 8 * lq)); }
#pragma unroll
            for (int ct = 0; ct < 4; ++ct) {
#pragma unroll
                for (int js = 0; js < 2; ++js) accO[ct] = mfma16(vf[js], LFRAG(G_QK + ((16 * ct + l15) * 72 + js * 32 + 8 * lq) * 2), accO[ct]);
                *(LAS f32x4*)(L + ((16 * ct + l15) * 132 + 16 * wave + 4 * lq) * 4) = accO[ct];
                asm volatile("" ::: "memory"); }
            const float egl = SM[192];
#pragma unroll
            for (int kt = 0; kt < 8; ++kt) { accS[kt] = accS[kt] * egl;
#pragma unroll
                for (int js = 0; js < 2; ++js) accS[kt] = mfma16(vsf[js], LFRAG(G_KT + tofs(16 * kt + l15, js * 32 + 8 * lq)), accS[kt]);
#pragma unroll
                for (int jj = 0; jj < 4; ++jj) *(LAS bf16_t*)(L + G_SB + ((16 * wave + 4 * lq + jj) * 136 + 16 * kt + l15) * 2) = f2bf(accS[kt][jj]);
                asm volatile("" ::: "memory"); }
        }
        lds_barrier();
#pragma unroll
        for (int q = 0; q < 8; ++q) { const int c = wave + 8 * q;
            if (c < nvalid) {
                const f32x2 o = *(const LAS f32x2*)(L + (c * 132 + 2 * lane) * 4);
                const float ss = wave_sum(o[0] * o[0] + o[1] * o[1]); const float rinv = rsqrtf(ss * (1.f / 128.f) + 1e-6f);
                const size_t row = (size_t)(r0 + c); const int col = h * 128 + 2 * lane;
                const unsigned zz = zz8[q], ga = ga8[q];
                const float o0 = o[0] * rinv * ng0 * siluf(bflo(zz)) * sigm(bflo(ga)), o1 = o[1] * rinv * ng1 * siluf(bfhi(zz)) * sigm(bfhi(ga));
                *(unsigned*)(MG + row * 1024 + col) = cvt_pk_bf16(o0, o1); } }
        lds_barrier();
    }
    { int so = l15 * 128 + 16 * wave + 4 * lq; asm volatile("" : "+v"(so));
#pragma unroll
      for (int kt = 0; kt < 8; ++kt) *(f32x4*)(Sout + (size_t)(so + kt * 2048)) = accS[kt]; }
}
constexpr int R_OP = 57344, R_YB = 114688;
__device__ __forceinline__ void rwkv_seq(const Params& p, lds_t L, int s, int rbase, int T, bool samp, int b, int h, const float* Sin, float* Sout) {
    const bf16_t* P = (const bf16_t*)(p.ws + W_P); const bf16_t* LR = (const bf16_t*)(p.ws + W_L); bf16_t* MG = (bf16_t*)(p.ws + W_MG);
    const bf16_t* SC = (const bf16_t*)(p.ws + W_SC);
    const int tid = ltid(), lane = tid & 63, wave = tid >> 6;
    const int NT = (T + 15) / 16;
    const bool scanner = wave < 4;
    typedef float f32x16 __attribute__((ext_vector_type(16)));
    const int hh_s = wave >> 1, half = wave & 1, cl = lane & 31, hf = lane >> 5;
    f32x16 T0, T1;
    const int hh_l = wave & 1, st0 = (wave < 4) ? 2 * (wave >> 1) : 4 + 6 * ((wave - 4) >> 1);
    const int hg_s = 2 * h + hh_s;
    const int hg = 2 * h + hh_l;
    const int hc = hg * 64 + lane;
    const size_t lbase = samp ? ((size_t)MPR * 3072 + (size_t)((b * 8 + h) * NSS) * 384) : ((size_t)((b * 8 + h) * TS) * 384);
    float c_mur = 0.f, c_muk = 0.f, c_muv = 0.f, c_w0 = 0.f, c_a0 = 0.f, c_kk = 0.f, c_ka = 0.f, c_rk = 0.f, c_lg = 0.f, c_lb = 0.f, c_pr = 0.f, c_pk = 0.f, c_pv = 0.f;
    if (scanner) {
#pragma unroll
        for (int g = 0; g < 4; ++g) { f32x4 t0 = (f32x4){0.f, 0.f, 0.f, 0.f}, t1 = t0;
            if (Sin) { const float* sp = Sin + ((size_t)hg_s * 64 + 32 * half + cl) * 64 + 8 * g + 4 * hf; t0 = *(const f32x4*)sp; t1 = *(const f32x4*)(sp + 32); }
#pragma unroll
            for (int q = 0; q < 4; ++q) { T0[4 * g + q] = t0[q]; T1[4 * g + q] = t1[q]; } }
        float one = 1.0f; asm volatile("" : "+v"(one)); T0 *= one; T1 *= one;
    }
    {
        if (samp) { c_pr = p.in[4][(size_t)b * CB + hc]; c_pk = p.in[4][(size_t)b * CB + 1024 + hc]; c_pv = p.in[4][(size_t)b * CB + 2048 + hc]; }
        else if (s > 0) { const bf16_t* sc = SC + ((size_t)((s & 1) * NB + b)) * CB; c_pr = bf2f(sc[hc]); c_pk = bf2f(sc[1024 + hc]); c_pv = bf2f(sc[2048 + hc]); }
    }
    typedef unsigned short us2 __attribute__((ext_vector_type(2)));
    struct RawA { us2 rk[6], vl[6], ll[6], q0, q1; };
    struct RawB { us2 go[6]; };
    auto issueA = [&](auto nqc, int nl, RawA& a) {
        constexpr int NQ = decltype(nqc)::value;
        const int tb = nl * 16 + st0;
#pragma unroll
        for (int q = 0; q < NQ; ++q) { const size_t row = (size_t)(rbase + tb + q); const bf16_t* Pr = P + row * NPAD + C_PB; const bf16_t* Lr = LR + lbase + (size_t)((tb + q) * 2 + hh_l) * 192 + lane;
            a.rk[q].x = Pr[hc]; a.rk[q].y = Pr[1024 + hc]; a.vl[q].x = Pr[2048 + hc]; a.vl[q].y = Lr[0]; a.ll[q].x = Lr[64]; a.ll[q].y = Lr[128]; }
        if (tb > 0) { const bf16_t* Pq = P + (size_t)(rbase + tb - 1) * NPAD + C_PB; a.q0.x = Pq[hc]; a.q0.y = Pq[1024 + hc]; a.q1.x = Pq[2048 + hc]; a.q1.y = 0; }
        else { a.q0.x = 0; a.q0.y = 0; a.q1.x = 0; a.q1.y = 1; }
    };
    auto issueB = [&](auto nqc, int np, RawB& bq) {
        constexpr int NQ = decltype(nqc)::value;
        const int tb = np * 16 + st0;
#pragma unroll
        for (int q = 0; q < NQ; ++q) { const size_t row = (size_t)(rbase + tb + q); bq.go[q].x = P[row * NPAD + C_GB + hc]; bq.go[q].y = MG[row * 1024 + hc]; }
    };
    auto postcalc = [&](auto nqc, int np, float (&outv)[6]) {
        constexpr int NQ = decltype(nqc)::value;
        int hl = hc; asm volatile("" : "+v"(hl));
        const float c_rk = p.in[19][hl], c_lg = p.in[20][hl], c_lb = p.in[21][hl];
        const LAS float* OP = (const LAS float*)(L + (np & 1) * R_OP); const LAS float* YB = (const LAS float*)(L + R_YB + (np & 1) * 8192);
        float y[NQ], m[NQ], bs[NQ], vq[NQ], gq[NQ];
#pragma unroll
        for (int q = 0; q < NQ; ++q) { const int tt = st0 + q; const LAS float* o = OP + ((hh_l * 16 + tt) * 7) * 64 + lane;
            y[q] = YB[(hh_l * 16 + tt) * 64 + lane]; m[q] = y[q]; bs[q] = o[256] * o[192] * c_rk; vq[q] = o[320]; gq[q] = o[384]; }
        wave_sumN<NQ>(m); wave_sumN<NQ>(bs);
        float d[NQ], var[NQ];
#pragma unroll
        for (int q = 0; q < NQ; ++q) { d[q] = y[q] - m[q] * (1.f / 64.f); var[q] = d[q] * d[q]; }
        wave_sumN<NQ>(var);
#pragma unroll
        for (int q = 0; q < NQ; ++q) { const float yn = d[q] * rsqrtf(var[q] * (1.f / 64.f) + 64e-5f) * c_lg + c_lb; outv[q] = (yn + bs[q] * vq[q]) * gq[q]; }
    };
    auto postwrite = [&](auto nqc, int np, const RawB& bq, const float (&outv)[6]) {
        constexpr int NQ = decltype(nqc)::value;
        const int tb = np * 16 + st0;
        float eg[NQ];
#pragma unroll
        for (int q = 0; q < NQ; ++q) eg[q] = __expf(-bf2f(bq.go[q].x));
#pragma unroll
        for (int q = 0; q < NQ; ++q) eg[q] = __builtin_amdgcn_rcpf(1.0f + eg[q]);
#pragma unroll
        for (int q = 0; q < NQ; ++q) { const size_t row = (size_t)(rbase + tb + q); MG[row * 1024 + hc] = f2bf(bf2f(bq.go[q].y) + eg[q] * outv[q]); }
    };
    auto transform = [&](auto nqc, int nl, const RawA& a) {
        constexpr int NQ = decltype(nqc)::value;
        LAS float* OP = (LAS float*)(L + (nl & 1) * R_OP);
        int hl = hc; asm volatile("" : "+v"(hl));
        const float c_mur = p.in[11][hl], c_muk = p.in[11][1024 + hl], c_muv = p.in[11][2048 + hl], c_w0 = p.in[12][hl], c_a0 = p.in[14][hl], c_kk = p.in[17][hl], c_ka = p.in[18][hl];
        float qr = c_pr, qk = c_pk, qv = c_pv;
        if (a.q1.y == 0) { qr = bf2f(a.q0.x); qk = bf2f(a.q0.y); qv = bf2f(a.q1.x); }
        float xr[NQ], xk[NQ], xv[NQ], kkv[NQ], ss[NQ], e1[NQ], e2[NQ];
#pragma unroll
        for (int q = 0; q < NQ; ++q) { const float pr = bf2f(a.rk[q].x), pk = bf2f(a.rk[q].y), pv = bf2f(a.vl[q].x);
            xr[q] = pr + c_mur * (qr - pr); xk[q] = pk + c_muk * (qk - pk); xv[q] = pv + c_muv * (qv - pv); qr = pr; qk = pk; qv = pv;
            kkv[q] = xk[q] * c_kk; ss[q] = kkv[q] * kkv[q]; }
        wave_sumN<NQ>(ss);
#pragma unroll
        for (int q = 0; q < NQ; ++q) { e1[q] = __expf(-(c_w0 + bf2f(a.vl[q].y))); e2[q] = __expf(-(c_a0 + bf2f(a.ll[q].x))); }
        float sw[NQ], asig[NQ], rn[NQ];
#pragma unroll
        for (int q = 0; q < NQ; ++q) { sw[q] = __builtin_amdgcn_rcpf(1.0f + e1[q]); asig[q] = __builtin_amdgcn_rcpf(1.0f + e2[q]); rn[q] = rsqrtf(ss[q] + 1e-6f); }
        float dec[NQ];
#pragma unroll
        for (int q = 0; q < NQ; ++q) dec[q] = __expf(-0.6065306597126334f * sw[q]);
#pragma unroll
        for (int q = 0; q < NQ; ++q) { const int tt = st0 + q; const float kk = kkv[q] * rn[q]; const float kmod = xk[q] * (1.f + (asig[q] - 1.f) * c_ka);
            LAS float* o = OP + ((hh_l * 16 + tt) * 7) * 64 + lane;
            o[0] = dec[q]; o[64] = -kk; o[128] = kk * asig[q]; o[192] = kmod; o[256] = xr[q]; o[320] = xv[q]; o[384] = bf2f(a.ll[q].y); }
    };
    auto scan_tile = [&](const LAS float* OP, LAS float* YB) {
        const int roff = 4 * hf;
        const int abase = (hf ? 192 : 128) + cl;
        float yp_prev = 0.f, yo_prev = 0.f;
        for (int tt = 0; tt < 16; ++tt) {
            const LAS float* op = OP + ((hh_s * 16 + tt) * 7) * 64;
            f32x4 ar[2][4], wr[2][4], rr[2][4];
#pragma unroll
            for (int jb = 0; jb < 2; ++jb)
#pragma unroll
                for (int g = 0; g < 4; ++g) ar[jb][g] = *(const LAS f32x4*)(op + 64 + 32 * jb + 8 * g + roff);
#pragma unroll
            for (int jb = 0; jb < 2; ++jb)
#pragma unroll
                for (int g = 0; g < 4; ++g) { wr[jb][g] = *(const LAS f32x4*)(op + 32 * jb + 8 * g + roff); rr[jb][g] = *(const LAS f32x4*)(op + 256 + 32 * jb + 8 * g + roff); }
            const float aop0 = op[abase], aop1 = op[abase + 32], vv = op[320 + 32 * half + cl];
            f32x4 acc = (f32x4){0.f, 0.f, 0.f, 0.f}, acd = acc;
#pragma unroll
            for (int g = 0; g < 4; ++g) { const f32x4 t0 = (f32x4){T0[4 * g], T0[4 * g + 1], T0[4 * g + 2], T0[4 * g + 3]}, t1 = (f32x4){T1[4 * g], T1[4 * g + 1], T1[4 * g + 2], T1[4 * g + 3]};
                acc += t0 * ar[0][g]; acd += t1 * ar[1][g]; }
            acc += acd;
            const float part = (acc[0] + acc[1]) + (acc[2] + acc[3]);
            const float other = __shfl_xor(part, 32);
#pragma unroll
            for (int g = 0; g < 4; ++g)
#pragma unroll
                for (int q = 0; q < 4; ++q) { T0[4 * g + q] *= wr[0][g][q]; T1[4 * g + q] *= wr[1][g][q]; }
            if (tt > 0 && hf == 0) YB[(hh_s * 16 + tt - 1) * 64 + 32 * half + cl] = yp_prev + yo_prev;
            const float sa = part + other;
            const float bop = hf ? vv : sa;
            T0 = __builtin_amdgcn_mfma_f32_32x32x2f32(aop0, bop, T0, 0, 0, 0);
            T1 = __builtin_amdgcn_mfma_f32_32x32x2f32(aop1, bop, T1, 0, 0, 0);
            f32x4 yc = (f32x4){0.f, 0.f, 0.f, 0.f}, yd = yc;
#pragma unroll
            for (int g = 0; g < 4; ++g) { const f32x4 t0 = (f32x4){T0[4 * g], T0[4 * g + 1], T0[4 * g + 2], T0[4 * g + 3]}, t1 = (f32x4){T1[4 * g], T1[4 * g + 1], T1[4 * g + 2], T1[4 * g + 3]};
                yc += t0 * rr[0][g]; yd += t1 * rr[1][g]; }
            yc += yd;
            yp_prev = (yc[0] + yc[1]) + (yc[2] + yc[3]);
            yo_prev = __shfl_xor(yp_prev, 32);
        }
        if (hf == 0) YB[(hh_s * 16 + 15) * 64 + 32 * half + cl] = yp_prev + yo_prev;
    };
    auto work = [&](auto nqc, int n, RawA& Acur, RawA& Anext) {
        RawB Bq; float outv[6];
        if (scanner) { const LAS float* OP = (const LAS float*)(L + (n & 1) * R_OP); LAS float* YB = (LAS float*)(L + R_YB + (n & 1) * 8192); __builtin_amdgcn_s_setprio(3); scan_tile(OP, YB); __builtin_amdgcn_s_setprio(0); }
        if (n >= 1) issueB(nqc, n - 1, Bq);
        if (n + 2 < NT) issueA(nqc, n + 2, Anext);
        if (n >= 1) postcalc(nqc, n - 1, outv);
        if (n + 1 < NT) transform(nqc, n + 1, Acur);
        if (n >= 1) postwrite(nqc, n - 1, Bq, outv);
    };
    auto iter = [&](int n, RawA& Acur, RawA& Anext) {
        if (scanner) work(IC<2>{}, n, Acur, Anext); else work(IC<6>{}, n, Acur, Anext);
        lds_barrier();
    };
    RawA A0, A1;
    if (scanner) { issueA(IC<2>{}, 0, A1); transform(IC<2>{}, 0, A1); if (NT > 1) issueA(IC<2>{}, 1, A0); }
    else { issueA(IC<6>{}, 0, A1); transform(IC<6>{}, 0, A1); if (NT > 1) issueA(IC<6>{}, 1, A0); }
    __syncthreads();
    for (int n = 0; n < NT; n += 2) {
        iter(n, A0, A1);
        if (n + 1 < NT) iter(n + 1, A1, A0);
    }
    { RawB Bq; float outv[6];
      if (scanner) { issueB(IC<2>{}, NT - 1, Bq); postcalc(IC<2>{}, NT - 1, outv); postwrite(IC<2>{}, NT - 1, Bq, outv); }
      else { issueB(IC<6>{}, NT - 1, Bq); postcalc(IC<6>{}, NT - 1, outv); postwrite(IC<6>{}, NT - 1, Bq, outv); } }
    if (scanner) {
#pragma unroll
        for (int g = 0; g < 4; ++g) { float* sp = Sout + ((size_t)hg_s * 64 + 32 * half + cl) * 64 + 8 * g + 4 * hf;
            *(f32x4*)sp = (f32x4){T0[4 * g], T0[4 * g + 1], T0[4 * g + 2], T0[4 * g + 3]}; *(f32x4*)(sp + 32) = (f32x4){T1[4 * g], T1[4 * g + 1], T1[4 * g + 2], T1[4 * g + 3]}; }
    }
    __syncthreads();
}

__device__ __forceinline__ void ph_seq(const Params& p, lds_t L, int s) {
    for (int blk = blockIdx.x; blk < NB * 8; blk += gridDim.x) {
        const int b = blk >> 3, h = blk & 7;
        float* gst = p.out + O_GP + ((size_t)(b * 8 + h)) * 16384;
#ifndef NO_GDN
        gdn_seq(p, L, b * TS, TS / 64, 64, (b << 6) + h, h, s > 0 ? gst : nullptr, gst);
#endif
        float* wst = p.out + O_WP + (size_t)b * 16 * 4096;
#ifndef NO_RWKV
        rwkv_seq(p, L, s, b * TS, TS, false, b, h, s > 0 ? wst : nullptr, wst);
#endif
    }
#ifndef NO_SAMP
    if (s == 0) for (int blk = blockIdx.x; blk < NSB * 8; blk += gridDim.x) {
        const int sb = blk >> 3, h = blk & 7;
        gdn_seq(p, L, MPR + sb * NSS, 1, NSS, NITEM_P + blk, h, p.in[3] + ((size_t)(sb * 8 + h)) * 16384, p.out + O_GS + ((size_t)(sb * 8 + h)) * 16384);
        rwkv_seq(p, L, s, MPR + sb * NSS, NSS, true, sb, h, p.in[5] + (size_t)sb * 16 * 4096, p.out + O_WS + (size_t)sb * 16 * 4096);
    }
#endif
}

#ifdef ONLY
#define EN(x) ((x) == ONLY)
#elif defined(ENMASK)
#define EN(x) (((ENMASK) >> ((x) == 100 ? 11 : (x))) & 1)
#else
#define EN(x) true
#endif

template <int MODE> __device__ __forceinline__ void skinny_gemm(const Params& p, lds_t L, const bf16_t* A, int lda, const bf16_t* Bt, int ldb, int N, int K) {
    const int tid = ltid(), lane = tid & 63, wave = tid >> 6, l15 = lane & 15, lq = lane >> 4;
    LAS float* red = (LAS float*)L;
    const int ntile = 8 * (N / 16), kw = K / 8;
    float* PL = (float*)(p.ws + W_PL); bf16_t* Fb = (bf16_t*)(p.ws + W_P);
    for (int t = blockIdx.x; t < ntile; t += gridDim.x) {
        const int tr = t & 7, tc = t >> 3;
        const bf16_t* ap = A + (size_t)(16 * tr + l15) * lda + wave * kw + 8 * lq;
        const bf16_t* bp = Bt + (size_t)(16 * tc + l15) * ldb + wave * kw + 8 * lq;
        f32x4 acc = (f32x4){0.f, 0.f, 0.f, 0.f};
        for (int k0 = 0; k0 < kw; k0 += 128) {
            u32x4 af[4], bf[4];
#pragma unroll
            for (int u = 0; u < 4; ++u) { af[u] = *(const u32x4*)(ap + k0 + 32 * u); bf[u] = *(const u32x4*)(bp + k0 + 32 * u); }
#pragma unroll
            for (int u = 0; u < 4; ++u) acc = mfma16(__builtin_bit_cast(bf16x8, af[u]), __builtin_bit_cast(bf16x8, bf[u]), acc);
        }
#pragma unroll
        for (int jj = 0; jj < 4; ++jj) red[wave * 256 + (4 * lq + jj) * 16 + l15] = acc[jj];
        __syncthreads();
        if (tid < 256) {
            float v = 0.f;
#pragma unroll
            for (int w = 0; w < 8; ++w) v += red[w * 256 + tid];
            const int r = 16 * tr + (tid >> 4), c = 16 * tc + (tid & 15); const size_t row = (size_t)(MPR + r);
            if (MODE == 0) PL[row * 1024 + c] = v + DN_ALPHA * p.in[1][(size_t)r * D + c];
            else if (MODE == 1) { const float a = fmaxf(v, 0.f); Fb[row * LDF + c] = f2bf(a * a); }
            else PL[row * 1024 + c] = v + DN_ALPHA * PL[row * 1024 + c];
        }
        __syncthreads();
    }
}
#define XB_TMO      128
#define XB_XCNT(j)  (256  + 64 * (j))
#define XB_XSUB(j)  (1280 + 64 * (j))
#define XB_XGEN(j)  (2304 + 64 * (j))
#define XB_TOP      3328
#define XB_TOPGEN   3392
#define XCD_BAR_WORDS 3456
#define XB_SPIN_CAP (1u << 20)
__device__ __forceinline__ unsigned xb_ld(unsigned* p)              { return __hip_atomic_load(p, __ATOMIC_RELAXED, __HIP_MEMORY_SCOPE_AGENT); }
__device__ __forceinline__ unsigned xb_add(unsigned* p, unsigned v) { return __hip_atomic_fetch_add(p, v, __ATOMIC_RELAXED, __HIP_MEMORY_SCOPE_AGENT); }
__device__ __forceinline__ unsigned xb_xcc_id() { return (unsigned)__builtin_amdgcn_s_getreg((3 << 11) | 20) & 0xFu; }
#define XB_SPIN(cond, bar) do { unsigned _sp = 0; while (cond) { __builtin_amdgcn_s_sleep(1); \
    if ((++_sp & 255u) == 0u) { if (xb_ld(&(bar)[XB_TMO])) break; if (_sp > XB_SPIN_CAP) { atomicAdd(&(bar)[XB_TMO], 1u); break; } } } } while (0)
struct XcdBarrier { unsigned* bar; unsigned x; volatile LAS unsigned* st; };
__device__ __forceinline__ XcdBarrier xcd_barrier_post(unsigned* bar, volatile LAS unsigned* st) {
    XcdBarrier b; b.bar = bar; b.x = xb_xcc_id(); b.st = st;
    if (threadIdx.x == 0) (void)xb_add(&bar[XB_XCNT(b.x)], 1u);
    return b;
}
__device__ __forceinline__ void xcd_barrier_complete(unsigned* bar, unsigned x, unsigned& nloc, unsigned& nx) {
    const unsigned G = gridDim.x * gridDim.y * gridDim.z;
    unsigned sum, cnt, mine, sp = 0u;
    for (;;) {
        sum = 0u; cnt = 0u; mine = 0u;
#pragma unroll
        for (unsigned j = 0; j < 16; ++j) { const unsigned c = xb_ld(&bar[XB_XCNT(j)]); sum += c; cnt += (c > 0u) ? 1u : 0u; mine = (j == x) ? c : mine; }
        if (sum == G) break;
        __builtin_amdgcn_s_sleep(1);
        if ((++sp & 255u) == 0u) { if (xb_ld(&bar[XB_TMO])) break; if (sp > XB_SPIN_CAP) { atomicAdd(&bar[XB_TMO], 1u); break; } }
    }
    nloc = mine > 0u ? mine : 1u; nx = cnt > 0u ? cnt : 1u;
}
__device__ __forceinline__ void xcd_barrier(const XcdBarrier& b) {
    asm volatile("s_waitcnt vmcnt(0)" ::: "memory");
    __syncthreads();
    if (threadIdx.x == 0) {
        unsigned* bar = b.bar;
        __builtin_amdgcn_s_waitcnt(0);
        unsigned nloc = b.st[0], nx = b.st[1];
        if (nloc == 0u) { xcd_barrier_complete(bar, b.x, nloc, nx); b.st[0] = nloc; b.st[1] = nx; }
        const unsigned old = xb_add(&bar[XB_XSUB(b.x)], 1u);
        const unsigned gen = old / nloc;
        if (old + 1u == (gen + 1u) * nloc) {
            __builtin_amdgcn_fence(__ATOMIC_RELEASE, "agent");
            asm volatile("s_waitcnt vmcnt(0)" ::: "memory");
            const unsigned og = xb_add(&bar[XB_TOP], 1u);
            const unsigned tg = og / nx;
            if (og + 1u == (tg + 1u) * nx) xb_add(&bar[XB_TOPGEN], 1u);
            else XB_SPIN(xb_ld(&bar[XB_TOPGEN]) == tg, bar);
            __builtin_amdgcn_fence(__ATOMIC_ACQUIRE, "agent");
            xb_add(&bar[XB_XGEN(b.x)], 1u);
            asm volatile("s_waitcnt vmcnt(0)" ::: "memory");
        } else {
            XB_SPIN(xb_ld(&bar[XB_XGEN(b.x)]) == gen, bar);
            __builtin_amdgcn_fence(__ATOMIC_ACQUIRE, "agent");
            asm volatile("s_waitcnt vmcnt(0)" ::: "memory");
        }
    }
    __syncthreads();
}
constexpr int PPS = 8;
constexpr int NPHASE = 1 + NSEG * PPS + 1;
__global__ __launch_bounds__(512, 2) void mega(Params p) {
    extern __shared__ __attribute__((aligned(16))) unsigned char shm[];
    lds_t L = (lds_t)shm;
    cg::grid_group grid = cg::this_grid();
    volatile LAS unsigned* st = (volatile LAS unsigned*)(L + (LDS_BYTES - 16));
    if (threadIdx.x == 0) { st[0] = 0u; st[1] = 0u; }
    __syncthreads();
    const XcdBarrier xb = xcd_barrier_post((unsigned*)(p.ws + W_BAR), st);
    int redone = 0;
    for (int ph = p.ph_lo; ph < p.ph_hi; ++ph) {
        if (ph == 0) ph_wprep(p, L);
        else if (ph == NPHASE - 1) ph_ln<1>(p, NSEG - 1);
        else {
            const int s = (ph - 1) / PPS, k = (ph - 1) % PPS;
            const int mps = (s == 0) ? MP : MPR;
            if (k == 0 || k == 2) {
                if (k == 0 && s > 0) ph_ln<1>(p, s - 1);
                pg8::Gemm g; EpiB16<0> E;
                if (k == 0) { g.A = (const bf16_t*)(p.ws + W_XB) + xb_row0(s) * 1024; g.Bt = (const bf16_t*)(p.ws + W_WIN); g.M = mps; g.N = NPAD; g.K = 1024; g.lda = 1024; g.ldb = 1024; E.O = (bf16_t*)(p.ws + W_P); E.ldc = NPAD; E.hm = 0; }
                else { g.A = (const bf16_t*)(p.ws + W_LA); g.Bt = (const bf16_t*)(p.ws + W_WLORA); g.M = mps; g.N = 3072; g.K = 256; g.lda = 256; g.ldb = 256; E.O = (bf16_t*)(p.ws + W_L); E.ldc = 3072; E.hm = 1; }
                pg8::StaticOrder S; S.init(g.M, g.N, (int)gridDim.x, (int)blockIdx.x);
                pg8::gemm_phase<EpiB16<0>, pg8::StaticOrder, false>(L, g, S, E, nullptr);
                if (k == 2) { __syncthreads(); ph_gdnpre(p, L, s); }
            }
            else if (k == 1) ph_prep(p, s);
            else if (k == 3) ph_seq(p, L, s);
            else if (k == 4 || k == 7) {
                pg8::Gemm g; EpiAdd E; E.C = (float*)(p.ws + W_PL); E.xp = p.in[0]; E.xs = p.in[1]; E.s = s;
                if (k == 4) { g.A = (const bf16_t*)(p.ws + W_MG); g.Bt = (const bf16_t*)(p.ws + W_WOUT); g.M = MPR; g.N = 1024; g.K = 1024; g.lda = 1024; g.ldb = 1024; E.mode = 0; }
                else { g.A = (const bf16_t*)(p.ws + W_P); g.Bt = (const bf16_t*)(p.ws + W_WFF2); g.M = MPR; g.N = 1024; g.K = 4096; g.lda = LDF; g.ldb = LDF; E.mode = 1; }
                pg8::StaticOrder S; S.init(g.M, g.N, (int)gridDim.x, (int)blockIdx.x);
                pg8::gemm_phase<EpiAdd, pg8::StaticOrder, false>(L, g, S, E, nullptr);
                if (s == 0) { __syncthreads();
                    if (k == 4) skinny_gemm<0>(p, L, (const bf16_t*)(p.ws + W_MG) + (size_t)MPR * 1024, 1024, (const bf16_t*)(p.ws + W_WOUT), 1024, 1024, 1024);
                    else skinny_gemm<2>(p, L, (const bf16_t*)(p.ws + W_P) + (size_t)MPR * LDF, LDF, (const bf16_t*)(p.ws + W_WFF2), LDF, 1024, 4096); }
            }
            else if (k == 5) ph_ln<0>(p, s);
            else {
                pg8::Gemm g; EpiB16<1> E; g.A = (const bf16_t*)(p.ws + W_HB); g.Bt = (const bf16_t*)(p.ws + W_WFF1); g.M = MPR; g.N = 4096; g.K = 1024; g.lda = 1024; g.ldb = 1024; E.O = (bf16_t*)(p.ws + W_P); E.ldc = LDF; E.hm = 0;
                pg8::StaticOrder S; S.init(g.M, g.N, (int)gridDim.x, (int)blockIdx.x);
                pg8::gemm_phase<EpiB16<1>, pg8::StaticOrder, false>(L, g, S, E, nullptr);
                if (s == 0) { __syncthreads(); skinny_gemm<1>(p, L, (const bf16_t*)(p.ws + W_HB) + (size_t)MPR * 1024, 1024, (const bf16_t*)(p.ws + W_WFF1), 1024, 4096, 1024); }
            }
        }
        if (ph + 1 < p.ph_hi) { if (p.rep_mask == 0x7fffffff) grid.sync();   xcd_barrier(xb); }
        if ((p.rep_mask & 0x100000) && ph >= 1 && ph < NPHASE - 1 && ((ph - 1) % PPS) == 2 && !((redone >> ((ph - 1) / PPS)) & 1)) { redone |= 1 << ((ph - 1) / PPS); ph -= 3; }
    }
}

#ifndef REP_MASK
#define REP_MASK 0
#endif
extern "C" void kernel_launch(void* const* d_in, const int* in_sizes, int n_in, void* d_out, int out_size, void* d_ws, size_t ws_size, hipStream_t stream) {
    static int grid = 0;
    if (grid == 0) {
        int dev = 0, cus = 0, per_cu = 0;
        hipGetDevice(&dev);
        hipDeviceGetAttribute(&cus, hipDeviceAttributeMultiprocessorCount, dev);
        if (hipFuncSetAttribute((const void*)mega, hipFuncAttributeMaxDynamicSharedMemorySize, LDS_BYTES) != hipSuccess) { fprintf(stderr, "hipFuncSetAttribute failed\n"); }
        if (hipOccupancyMaxActiveBlocksPerMultiprocessor(&per_cu, (const void*)mega, 512, LDS_BYTES) != hipSuccess || per_cu < 1) { fprintf(stderr, "occupancy query: %d\n", per_cu); per_cu = 1; }
        (void)hipGetLastError();
        grid = cus * 1;
        if (ws_size < W_END) { fprintf(stderr, "workspace too small: %zu < %zu\n", ws_size, (size_t)W_END); grid = -1; }
    }
    if (grid < 0) return;
    (void)hipMemsetAsync((unsigned char*)d_ws + W_BAR, 0, 16384, stream);
    Params p{};
    for (int i = 0; i < 29; ++i) p.in[i] = (const float*)d_in[i];
    p.out = (float*)d_out; p.ws = (unsigned char*)d_ws; p.rep_mask = REP_MASK;
#if defined(MK_MULTI)
    for (int ph = 0; ph < NPHASE; ++ph) { p.ph_lo = ph; p.ph_hi = ph + 1; hipLaunchKernelGGL(mega, dim3(grid), dim3(512), LDS_BYTES, stream, p); }
#else
    p.ph_lo = 0; p.ph_hi = NPHASE;
    void* args[] = {&p};
    hipError_t e = hipLaunchCooperativeKernel((const void*)mega, dim3(grid), dim3(512), args, LDS_BYTES, stream);
    if (e != hipSuccess) fprintf(stderr, "cooperative launch failed: %s (grid %d)\n", hipGetErrorString(e), grid);
#endif
}
```
